# Optimizing an MI355X kernel written in HIP

```python
import math
import jax, jax.numpy as jnp
from jax import lax
import numpy as np

D_MODEL = 1024
BATCH = 8
SEQ = 2048
DEPTH = 1
DEC_BATCH = 128
DEC_SEQ = 4
PAST_LEN = 8192
PAGE_SIZE = 128

N_HEADS_A = 8
N_KV_A = 2
HEAD_DIM_A = 64
GROUP_A = N_HEADS_A // N_KV_A
WINDOW = 128
ATTN_BLOCK = 128
N_HEADS_M = 4
HEAD_DIM_M = 128
MLSTM_CHUNK = 64
D_FF = 2816
CONV_W = 3
PLE_DIM = 256
EPS = 1e-6

QA = N_HEADS_A * HEAD_DIM_A
KVA = N_KV_A * HEAD_DIM_A
DM = N_HEADS_M * HEAD_DIM_M
SPLITS = (QA, KVA, KVA, DM, DM, DM, DM, N_HEADS_M, N_HEADS_M, D_MODEL, D_MODEL)
D_IN = sum(SPLITS)

kernel_name = 'hybrid_swa_mlstm_convffn_decode_step'


def rmsnorm(x, g):
    xf = x.astype(jnp.float32)
    y = xf * lax.rsqrt(jnp.mean(xf * xf, axis=-1, keepdims=True) + EPS)
    return (y * g.astype(jnp.float32)).astype(x.dtype)


def alibi_slopes():
    h = jnp.arange(N_HEADS_A, dtype=jnp.float32) + 1.0
    return (2.0 ** (-8.0 * h / N_HEADS_A)).reshape(N_KV_A, GROUP_A)


def sink_attend(q, k, v, dist, valid, sinks):
    s = jnp.einsum('...qkgd,...skd->...kgqs', q, k).astype(jnp.float32) * (HEAD_DIM_A ** -0.5)
    s = s - alibi_slopes()[:, :, None, None] * dist[..., None, None, :, :]
    s = jnp.where(valid[..., None, None, :, :], s, -jnp.inf)
    sink = sinks.astype(jnp.float32).reshape(N_KV_A, GROUP_A)[:, :, None, None]
    mx = jnp.maximum(jnp.max(s, axis=-1, keepdims=True), sink)
    e = jnp.exp(s - mx)
    p = e / (jnp.sum(e, axis=-1, keepdims=True) + jnp.exp(sink - mx))
    return jnp.einsum('...kgqs,...skd->...qkgd', p.astype(v.dtype), v)


def window_attn_prompt(q, k, v, sinks):
    B, S = q.shape[:2]
    nb = S // ATTN_BLOCK
    qb = q.reshape(B, nb, ATTN_BLOCK, N_KV_A, GROUP_A, HEAD_DIM_A)
    pad = ((0, 0), (ATTN_BLOCK, 0), (0, 0), (0, 0))
    kb = jnp.pad(k, pad).reshape(B, nb + 1, ATTN_BLOCK, N_KV_A, HEAD_DIM_A)
    vb = jnp.pad(v, pad).reshape(B, nb + 1, ATTN_BLOCK, N_KV_A, HEAD_DIM_A)
    kc = jnp.concatenate([kb[:, :-1], kb[:, 1:]], axis=2)
    vc = jnp.concatenate([vb[:, :-1], vb[:, 1:]], axis=2)
    i = jnp.arange(ATTN_BLOCK)[:, None]
    j = jnp.arange(2 * ATTN_BLOCK)[None, :]
    dist = i + ATTN_BLOCK - j
    band = (dist >= 0) & (dist <= WINDOW)
    real = (jnp.arange(nb)[:, None, None] > 0) | (j[None] >= ATTN_BLOCK)
    valid = band[None] & real
    o = sink_attend(qb, kc, vc, dist.astype(jnp.float32), valid, sinks)
    return o.reshape(B, S, QA)


def window_attn_sample(q, k_new, v_new, k_buf, v_buf, sinks):
    DB, T = q.shape[:2]
    kc = jnp.concatenate([k_buf.astype(k_new.dtype), k_new], axis=1)
    vc = jnp.concatenate([v_buf.astype(v_new.dtype), v_new], axis=1)
    i = jnp.arange(T)[:, None]
    j = jnp.arange(WINDOW + T)[None, :]
    dist = i + WINDOW - j
    valid = (dist >= 0) & (dist <= WINDOW)
    o = sink_attend(q.reshape(DB, T, N_KV_A, GROUP_A, HEAD_DIM_A), kc, vc,
                    dist.astype(jnp.float32), valid, sinks)
    return o.reshape(DB, T, QA), kc[:, -WINDOW:], vc[:, -WINDOW:]


def mlstm_chunkwise(q, k, v, ig, lf, C0, n0, m0):
    B, T, H, d = q.shape
    L = math.gcd(T, MLSTM_CHUNK)
    nc = T // L

    def to_chunks(a):
        a = a.reshape((B, nc, L) + a.shape[2:])
        return jnp.moveaxis(jnp.moveaxis(a, 3, 2), 1, 0)

    causal = jnp.tril(jnp.ones((L, L), dtype=bool))

    def step(carry, xs):
        C, n, m = carry
        qc, kc, vc, ic, fc = xs
        F = jnp.cumsum(fc, axis=-1)
        Dm = jnp.where(causal, F[..., :, None] - F[..., None, :] + ic[..., None, :], -jnp.inf)
        inter = F + m[..., None]
        mt = jnp.maximum(inter, jnp.max(Dm, axis=-1))
        a_inter = jnp.exp(inter - mt)
        qk = jnp.einsum('bhtd,bhsd->bhts', qc, kc) * jnp.exp(Dm - mt[..., None])
        num = a_inter[..., None] * jnp.einsum('bhtd,bhde->bhte', qc, C) + jnp.einsum('bhts,bhse->bhte', qk, vc)
        den = a_inter * jnp.einsum('bhtd,bhd->bht', qc, n) + jnp.sum(qk, axis=-1)
        h = num / jnp.maximum(jnp.abs(den), jnp.exp(-mt))[..., None]
        m_new = mt[..., -1]
        FL = F[..., -1]
        dec = jnp.exp(FL + m - m_new)
        ws = jnp.exp(FL[..., None] - F + ic - m_new[..., None])
        C_new = dec[..., None, None] * C + jnp.einsum('bhs,bhsd,bhse->bhde', ws, kc, vc)
        n_new = dec[..., None] * n + jnp.einsum('bhs,bhsd->bhd', ws, kc)
        return (C_new, n_new, m_new), h

    xs = (to_chunks(q), to_chunks(k), to_chunks(v), to_chunks(ig), to_chunks(lf))
    (C1, n1, m1), hs = lax.scan(step, (C0, n0, m0), xs)
    h = jnp.moveaxis(jnp.moveaxis(hs, 0, 1), 2, 3).reshape(B, T, H, d)
    return h, C1, n1, m1


def conv_ffn(xn, conv_buf, w_up, conv_w, conv_b, w_down):
    B, T, _ = xn.shape
    u = xn @ w_up
    if conv_buf is None:
        conv_buf = jnp.zeros((B, CONV_W - 1, u.shape[-1]), u.dtype)
    uc = jnp.concatenate([conv_buf.astype(u.dtype), u], axis=1)
    y = conv_b
    for j in range(CONV_W):
        y = y + conv_w[j] * uc[:, j:j + T]
    a, b = jnp.split(y, 2, axis=-1)
    return (jax.nn.gelu(a) * b) @ w_down, uc[:, -(CONV_W - 1):]


def block(x, p, win_k, win_v, C0, n0, m0, conv_buf,
          g_mix, w_in, b_i, b_f, g_q, g_k, sinks, g_hm, w_oa, w_om, w_out,
          g_ffn, w_up, conv_w, conv_b, w_down, w_ple, w_ple_gate):
    B, T, _ = x.shape
    f32 = jnp.float32
    xn = rmsnorm(x, g_mix)
    z = xn @ w_in
    idx = np.cumsum(SPLITS)[:-1].tolist()
    q_a, k_a, v_a, q_m, k_m, v_m, o_m, i_m, f_m, ga, gm = jnp.split(z, idx, axis=-1)

    q_a = rmsnorm(q_a.reshape(B, T, N_HEADS_A, HEAD_DIM_A), g_q)
    k_a = rmsnorm(k_a.reshape(B, T, N_KV_A, HEAD_DIM_A), g_k)
    v_a = v_a.reshape(B, T, N_KV_A, HEAD_DIM_A)
    if win_k is None:
        y_a = window_attn_prompt(q_a, k_a, v_a, sinks)
        new_k, new_v = k_a[:, -WINDOW:], v_a[:, -WINDOW:]
    else:
        y_a, new_k, new_v = window_attn_sample(q_a, k_a, v_a, win_k, win_v, sinks)

    qm = q_m.reshape(B, T, N_HEADS_M, HEAD_DIM_M).astype(f32)
    km = k_m.reshape(B, T, N_HEADS_M, HEAD_DIM_M).astype(f32) * (HEAD_DIM_M ** -0.5)
    vm = v_m.reshape(B, T, N_HEADS_M, HEAD_DIM_M).astype(f32)
    ig = i_m.astype(f32) + b_i.astype(f32)
    lf = jax.nn.log_sigmoid(f_m.astype(f32) + b_f.astype(f32))
    if C0 is None:
        C0 = jnp.zeros((B, N_HEADS_M, HEAD_DIM_M, HEAD_DIM_M), f32)
        n0 = jnp.zeros((B, N_HEADS_M, HEAD_DIM_M), f32)
        m0 = jnp.zeros((B, N_HEADS_M), f32)
    hm, C1, n1, m1 = mlstm_chunkwise(qm, km, vm, ig, lf, C0.astype(f32), n0.astype(f32), m0.astype(f32))
    hm = rmsnorm(hm, g_hm.reshape(N_HEADS_M, HEAD_DIM_M)).reshape(B, T, DM).astype(x.dtype)
    hm = hm * jax.nn.sigmoid(o_m)

    mixed = jax.nn.sigmoid(ga) * (y_a @ w_oa) + jax.nn.sigmoid(gm) * (hm @ w_om)
    x = x + mixed @ w_out

    f, conv_new = conv_ffn(rmsnorm(x, g_ffn), conv_buf, w_up, conv_w, conv_b, w_down)
    x = x + f

    x = x + jax.nn.sigmoid(x @ w_ple_gate) * (p.astype(x.dtype) @ w_ple)
    return x, (new_k, new_v, C1, n1, m1, conv_new)


def setup_inputs(seed: int = 0) -> dict:
    key = jax.random.key(seed)
    ks = iter(jax.random.split(key, 40))

    def nrm(shape, scale):
        return jax.random.normal(next(ks), shape, jnp.float32) * scale

    F2 = 2 * D_FF
    return {
        'x_prompt': nrm((BATCH, SEQ, D_MODEL), 1.0),
        'x_sample': nrm((DEC_BATCH, DEC_SEQ, D_MODEL), 1.0),
        'cache_win_k': nrm((DEPTH, DEC_BATCH, WINDOW, N_KV_A, HEAD_DIM_A), 1.0),
        'cache_win_v': nrm((DEPTH, DEC_BATCH, WINDOW, N_KV_A, HEAD_DIM_A), 1.0),
        'state_mlstm_C': nrm((DEPTH, DEC_BATCH, N_HEADS_M, HEAD_DIM_M, HEAD_DIM_M), 0.05),
        'state_mlstm_n': nrm((DEPTH, DEC_BATCH, N_HEADS_M, HEAD_DIM_M), 0.1),
        'state_mlstm_m': nrm((DEPTH, DEC_BATCH, N_HEADS_M), 0.5),
        'state_ffn_conv': nrm((DEPTH, DEC_BATCH, CONV_W - 1, F2), 1.0),
        'p_prompt': nrm((DEPTH, BATCH, SEQ, PLE_DIM), 1.0),
        'p_sample': nrm((DEPTH, DEC_BATCH, DEC_SEQ, PLE_DIM), 1.0),
        'g_mix': 1.0 + nrm((DEPTH, D_MODEL), 0.02),
        'w_in': nrm((DEPTH, D_MODEL, D_IN), D_MODEL ** -0.5),
        'b_i': nrm((DEPTH, N_HEADS_M), 0.1),
        'b_f': jnp.linspace(3.0, 6.0, N_HEADS_M, dtype=jnp.float32)[None] + nrm((DEPTH, N_HEADS_M), 0.01),
        'g_q': 1.0 + nrm((DEPTH, HEAD_DIM_A), 0.02),
        'g_k': 1.0 + nrm((DEPTH, HEAD_DIM_A), 0.02),
        'sinks': nrm((DEPTH, N_HEADS_A), 0.5),
        'g_hm': 1.0 + nrm((DEPTH, DM), 0.02),
        'w_oa': nrm((DEPTH, QA, D_MODEL), QA ** -0.5),
        'w_om': nrm((DEPTH, DM, D_MODEL), DM ** -0.5),
        'w_out': nrm((DEPTH, D_MODEL, D_MODEL), D_MODEL ** -0.5),
        'g_ffn': 1.0 + nrm((DEPTH, D_MODEL), 0.02),
        'w_up': nrm((DEPTH, D_MODEL, F2), D_MODEL ** -0.5),
        'conv_w': nrm((DEPTH, CONV_W, F2), CONV_W ** -0.5),
        'conv_b': nrm((DEPTH, F2), 0.01),
        'w_down': nrm((DEPTH, D_FF, D_MODEL), D_FF ** -0.5),
        'w_ple': nrm((DEPTH, PLE_DIM, D_MODEL), PLE_DIM ** -0.5),
        'w_ple_gate': nrm((DEPTH, D_MODEL, D_MODEL), D_MODEL ** -0.5),
    }


def reference(x_prompt, x_sample, cache_win_k, cache_win_v, state_mlstm_C, state_mlstm_n,
              state_mlstm_m, state_ffn_conv, p_prompt, p_sample,
              g_mix, w_in, b_i, b_f, g_q, g_k, sinks, g_hm, w_oa, w_om, w_out,
              g_ffn, w_up, conv_w, conv_b, w_down, w_ple, w_ple_gate):
    hp, hs = x_prompt, x_sample
    st_p, st_s = [], []
    for l in range(DEPTH):
        w = (g_mix[l], w_in[l], b_i[l], b_f[l], g_q[l], g_k[l], sinks[l], g_hm[l], w_oa[l], w_om[l],
             w_out[l], g_ffn[l], w_up[l], conv_w[l], conv_b[l], w_down[l], w_ple[l], w_ple_gate[l])
        hp, sp = block(hp, p_prompt[l], None, None, None, None, None, None, *w)
        hs, ss = block(hs, p_sample[l], cache_win_k[l], cache_win_v[l], state_mlstm_C[l],
                       state_mlstm_n[l], state_mlstm_m[l], state_ffn_conv[l], *w)
        st_p.append(sp)
        st_s.append(ss)
    kp, vp, Cp, np_, mp, cp = [jnp.stack(a) for a in zip(*st_p)]
    ks_, vs_, Cs, ns, ms, cs = [jnp.stack(a) for a in zip(*st_s)]
    return (hp, hs, kp, vp, Cp, np_, mp, cp, ks_, vs_, Cs, ns, ms, cs)
```

```cpp
#include <hip/hip_runtime.h>
#include <cstdio>
#include <cstdint>
#include <cmath>
namespace pg8 {
#define PG8_LAS __attribute__((address_space(3)))
typedef unsigned short bf16_t;
typedef short bf16x8 __attribute__((ext_vector_type(8)));
typedef float f32x4 __attribute__((ext_vector_type(4)));
typedef unsigned u32x4 __attribute__((ext_vector_type(4)));
constexpr int BM = 256, BK = 64, HALF = 128, HTB = HALF * BK * 2  , STAGE_BYTES = 8 * HTB, NXCD = 8, WGM = 8;

__host__ __device__ __forceinline__ int lds_byte(int r, int c) { const int st = (r >> 4) * 2 + (c >> 5), rr = r & 15, cc = c & 31, ob = rr * 64 + cc * 2; return st * 1024 + (ob ^ (((ob >> 9) & 1) << 5)); }
__host__ __device__ __forceinline__ void stage_rc(int b, int& R, int& C) { const int st = b / 1024, sb = b % 1024, swz = sb ^ (((sb >> 9) & 1) << 5); R = (st >> 1) * 16 + swz / 64; C = (st & 1) * 32 + (swz % 64) / 2; }
__host__ __device__ __forceinline__ int perm32(int rho) { const int n = rho >> 4, i = rho & 15; return 8 * (i >> 2) + 4 * n + (i & 3); }

struct Unit { int pm, pn; };
struct Gemm { const bf16_t* A; const bf16_t* Bt; int M, N, K; };

struct StaticOrder {
    int nM, nN, nwg, G, c;
    __host__ __device__ void init(int M, int N, int G_, int c_) { nM = M / BM; nN = N / BM; nwg = nM * nN; G = G_; c = c_; }
    __host__ __device__ bool next(int i, Unit& u) const {
        const long L = (long)i * G + c; if (L >= nwg) return false;
        int wgid = (int)L; { const int q = nwg / NXCD, r = nwg % NXCD, xcd = wgid % NXCD, off = wgid / NXCD; wgid = (xcd < r ? xcd * (q + 1) : r * (q + 1) + (xcd - r) * q) + off; }
        const int nig = WGM * nN, gid = wgid / nig, fm = gid * WGM, gsz = (nM - fm) < WGM ? (nM - fm) : WGM;
        u.pm = fm + ((wgid % nig) % gsz); u.pn = (wgid % nig) / gsz; return true;
    }
    __device__ __forceinline__ void a_ready(const Unit&) const {}
    __device__ __forceinline__ void done(const Unit&) const {}
};

template <class Epi, class Sched, bool ALIGN_EPI = false, bool SP2 = false>
__device__ __forceinline__ void gemm_phase(PG8_LAS unsigned char* lds, const Gemm g, const Sched& S, const Epi& E) {
    const int tid = threadIdx.x, wid = __builtin_amdgcn_readfirstlane(tid >> 6), lane = tid & 63, wr = wid >> 2, wc = wid & 3, fr = lane & 15, fq = lane >> 4;
    const int K = g.K, nt = K / BK;
    unsigned voffA[2], voffB[2];
#pragma unroll
    for (int i = 0; i < 2; ++i) { int R, C; stage_rc(tid * 16 + i * 8192, R, C); const int Rb = Epi::PERM ? ((R & ~31) + perm32(R & 31)) : R;
        voffA[i] = (unsigned)(R * K + C) * 2u; voffB[i] = (unsigned)(Rb * K + C) * 2u; }
    const size_t kstep = (size_t)(BK * 2);
    const size_t hstep = (size_t)HALF * K * 2;
    const size_t tstep = 2 * hstep;
    const unsigned ldsw = (unsigned)wid * 1024u;
    const int aoff = lds_byte(wr * 64 + fr, fq * 8), boff = lds_byte(wc * 32 + fr, fq * 8);
#define PG8_SA(b, h) (((b) * 2 + (h)) * HTB)
#define PG8_SB(b, h) ((4 + (b) * 2 + (h)) * HTB)
#define PG8_STAGE(bufoff, gbase, voff) do { _Pragma("unroll") for (int _i = 0; _i < 2; ++_i) \
        __builtin_amdgcn_global_load_lds((const unsigned*)((const char*)(gbase) + (voff)[_i]), (PG8_LAS unsigned*)(lds + (bufoff) + ldsw + _i * 8192), 16, 0, 0); } while (0)
#define PG8_LDA(dst, b, h) do { _Pragma("unroll") for (int m = 0; m < 4; ++m) _Pragma("unroll") for (int k = 0; k < 2; ++k) dst[m][k] = *(const PG8_LAS bf16x8*)(lds + PG8_SA(b, h) + aoff + m * 2048 + k * 1024); } while (0)
#define PG8_LDB(dst, b, h) do { _Pragma("unroll") for (int n = 0; n < 2; ++n) _Pragma("unroll") for (int k = 0; k < 2; ++k) dst[n][k] = *(const PG8_LAS bf16x8*)(lds + PG8_SB(b, h) + boff + n * 2048 + k * 1024); } while (0)
#define PG8_MMA(ai, bj, At, Bt) do { __builtin_amdgcn_s_setprio(1); _Pragma("unroll") for (int m = 0; m < 4; ++m) _Pragma("unroll") for (int n = 0; n < 2; ++n) _Pragma("unroll") for (int k = 0; k < 2; ++k) \
        acc[ai][bj][m][n] = __builtin_amdgcn_mfma_f32_16x16x32_bf16(Bt[n][k], At[m][k], acc[ai][bj][m][n], 0, 0, 0); __builtin_amdgcn_s_setprio(0); } while (0)
#define PG8_WAIT_V(n) asm volatile("s_waitcnt vmcnt(" #n ")" ::: "memory")
#define PG8_WAIT_L(n) asm volatile("s_waitcnt lgkmcnt(" #n ")" ::: "memory")
#define PG8_BAR __builtin_amdgcn_s_barrier()
#define PG8_SCHED __builtin_amdgcn_sched_barrier(0)
    Unit cur, nxt; int ui = 0;
    if (!S.next(0, cur)) return;
    f32x4 acc[2][2][4][2];
#pragma unroll
    for (int a = 0; a < 2; ++a)
#pragma unroll
        for (int b = 0; b < 2; ++b)
#pragma unroll
            for (int m = 0; m < 4; ++m)
#pragma unroll
                for (int n = 0; n < 2; ++n) acc[a][b][m][n] = (f32x4){0.f, 0.f, 0.f, 0.f};
    bf16x8 At[4][2], B0[2][2], B1[2][2];
    const char* cA = (const char*)g.A + (size_t)cur.pm * tstep; const char* cB = (const char*)g.Bt + (size_t)cur.pn * tstep;
    S.a_ready(cur);
    if constexpr (SP2) {
        PG8_STAGE(PG8_SB(0, 0), cB, voffB); PG8_STAGE(PG8_SB(0, 1), cB + hstep, voffB); PG8_STAGE(PG8_SA(0, 0), cA, voffA); PG8_STAGE(PG8_SA(0, 1), cA + hstep, voffA);
        if (wr == 1) PG8_BAR;
        PG8_WAIT_V(2); PG8_BAR;
        PG8_STAGE(PG8_SB(1, 0), cB + kstep, voffB); PG8_STAGE(PG8_SA(1, 0), cA + kstep, voffA); PG8_STAGE(PG8_SB(1, 1), cB + hstep + kstep, voffB);
        PG8_WAIT_V(6); PG8_BAR;
    } else {
        PG8_STAGE(PG8_SB(0, 0), cB, voffB); PG8_STAGE(PG8_SA(0, 0), cA, voffA); PG8_STAGE(PG8_SB(0, 1), cB + hstep, voffB); PG8_STAGE(PG8_SA(0, 1), cA + hstep, voffA);
        if (wr == 1) PG8_BAR;
        PG8_WAIT_V(4); PG8_BAR;
        PG8_STAGE(PG8_SB(1, 0), cB + kstep, voffB); PG8_STAGE(PG8_SA(1, 0), cA + kstep, voffA); PG8_STAGE(PG8_SB(1, 1), cB + hstep + kstep, voffB);
        PG8_WAIT_V(6); PG8_BAR;
    }
    for (;;) {
        const bool has_next = S.next(ui + 1, nxt);
        const char* nA = has_next ? (const char*)g.A + (size_t)nxt.pm * tstep : cA; const char* nB = has_next ? (const char*)g.Bt + (size_t)nxt.pn * tstep : cB;
        for (int t = 0; t < nt; t += 2) {
            const bool last = (t == nt - 2);
            const char* a1 = cA + (size_t)(t + 1) * kstep;
            const char* a2 = last ? nA : cA + (size_t)(t + 2) * kstep; const char* b2 = last ? nB : cB + (size_t)(t + 2) * kstep;
            const char* a3 = a2 + kstep; const char* b3 = b2 + kstep;
            if (last && has_next) S.a_ready(nxt);
            if constexpr (SP2) {
            PG8_LDB(B0, 0, 0); PG8_LDB(B1, 0, 1); PG8_SCHED; PG8_LDA(At, 0, 0); PG8_STAGE(PG8_SA(1, 1), a1 + hstep, voffA);
            PG8_WAIT_V(8); PG8_WAIT_L(0); PG8_BAR; PG8_MMA(0, 0, At, B0); PG8_MMA(0, 1, At, B1); PG8_BAR; PG8_SCHED;
            PG8_LDA(At, 0, 1); PG8_STAGE(PG8_SB(0, 0), b2, voffB); PG8_STAGE(PG8_SB(0, 1), b2 + hstep, voffB); PG8_STAGE(PG8_SA(0, 0), a2, voffA);
            PG8_WAIT_V(8); PG8_WAIT_L(0); PG8_BAR; PG8_MMA(1, 0, At, B0); PG8_MMA(1, 1, At, B1); PG8_BAR; PG8_SCHED;
            PG8_LDB(B0, 1, 0); PG8_LDB(B1, 1, 1); PG8_SCHED; PG8_LDA(At, 1, 0); PG8_STAGE(PG8_SA(0, 1), a2 + hstep, voffA);
            PG8_WAIT_V(8); PG8_WAIT_L(0); PG8_BAR; PG8_MMA(0, 0, At, B0); PG8_MMA(0, 1, At, B1); PG8_BAR; PG8_SCHED;
            PG8_LDA(At, 1, 1); PG8_STAGE(PG8_SB(1, 0), b3, voffB); PG8_STAGE(PG8_SB(1, 1), b3 + hstep, voffB); PG8_STAGE(PG8_SA(1, 0), a3, voffA);
            PG8_WAIT_V(8); PG8_WAIT_L(0); PG8_BAR; PG8_MMA(1, 0, At, B0); PG8_MMA(1, 1, At, B1); PG8_BAR; PG8_SCHED;
            } else {
            PG8_LDB(B0, 0, 0); PG8_SCHED; PG8_LDA(At, 0, 0); PG8_STAGE(PG8_SA(1, 1), a1 + hstep, voffA);
            PG8_WAIT_L(8); PG8_BAR; PG8_WAIT_L(0); PG8_MMA(0, 0, At, B0); PG8_BAR; PG8_SCHED;
            PG8_LDB(B1, 0, 1); PG8_STAGE(PG8_SB(0, 0), b2, voffB);
            PG8_BAR; PG8_WAIT_L(0); PG8_MMA(0, 1, At, B1); PG8_BAR;
            PG8_LDA(At, 0, 1); PG8_STAGE(PG8_SA(0, 0), a2, voffA);
            PG8_BAR; PG8_WAIT_L(0); PG8_MMA(1, 0, At, B0); PG8_BAR; PG8_SCHED;
            PG8_STAGE(PG8_SB(0, 1), b2 + hstep, voffB);
            PG8_WAIT_V(6); PG8_BAR; PG8_MMA(1, 1, At, B1); PG8_BAR;
            PG8_LDB(B0, 1, 0); PG8_SCHED; PG8_LDA(At, 1, 0); PG8_STAGE(PG8_SA(0, 1), a2 + hstep, voffA);
            PG8_WAIT_L(8); PG8_BAR; PG8_WAIT_L(0); PG8_MMA(0, 0, At, B0); PG8_BAR; PG8_SCHED;
            PG8_LDB(B1, 1, 1); PG8_STAGE(PG8_SB(1, 0), b3, voffB);
            PG8_BAR; PG8_WAIT_L(0); PG8_MMA(0, 1, At, B1); PG8_BAR;
            PG8_LDA(At, 1, 1); PG8_STAGE(PG8_SA(1, 0), a3, voffA);
            PG8_BAR; PG8_WAIT_L(0); PG8_MMA(1, 0, At, B0); PG8_BAR; PG8_SCHED;
            PG8_STAGE(PG8_SB(1, 1), b3 + hstep, voffB);
            PG8_WAIT_V(6); PG8_BAR; PG8_MMA(1, 1, At, B1); PG8_BAR;
            }
        }
        if constexpr (ALIGN_EPI) { if (wr == 0) PG8_BAR; }
        if constexpr (!Epi::AFTER_DRAIN) { E(acc, cur, wr, wc, fr, fq); S.done(cur); }
        if (!has_next) break;
#pragma unroll
        for (int a = 0; a < 2; ++a)
#pragma unroll
            for (int b = 0; b < 2; ++b)
#pragma unroll
                for (int m = 0; m < 4; ++m)
#pragma unroll
                    for (int n = 0; n < 2; ++n) acc[a][b][m][n] = (f32x4){0.f, 0.f, 0.f, 0.f};
        cur = nxt; cA = nA; cB = nB; ++ui;
        if constexpr (ALIGN_EPI) { if (wr == 1) PG8_BAR; }
    }
    PG8_WAIT_V(0);
    if constexpr (!ALIGN_EPI) { if (wr == 0) PG8_BAR; }
    PG8_BAR;
    if constexpr (Epi::AFTER_DRAIN) { E.fused(acc, cur, wr, wc, fr, fq, lds, wid, lane); S.done(cur); }
#undef PG8_SA
#undef PG8_SB
#undef PG8_STAGE
#undef PG8_LDA
#undef PG8_LDB
#undef PG8_MMA
#undef PG8_WAIT_V
#undef PG8_WAIT_L
#undef PG8_BAR
#undef PG8_SCHED
}
}

constexpr int D = 1024, NBATCH = 8, SEQ = 2048, DBATCH = 128, DSEQ = 4;
constexpr int MP = NBATCH * SEQ, MS = DBATCH * DSEQ, M = MP + MS;
constexpr int QAW = 512, KVW = 128, HDA = 64, DMW = 512, HDM = 128, WIN = 128;
constexpr int DFF = 2816, F2 = 5632, PLE = 256, DIN = 4872;
constexpr int N1 = 4864;
constexpr float EPS = 1e-6f;
constexpr float LOG2E = 1.4426950408889634f;
constexpr size_t O_Y = 0, O_WKP = (size_t)M * D, O_WVP = O_WKP + 131072, O_CP = O_WVP + 131072, O_NP = O_CP + 524288, O_MP = O_NP + 4096, O_CONVP = O_MP + 32,
                 O_WKS = O_CONVP + 90112, O_WVS = O_WKS + 2097152, O_CS = O_WVS + 2097152, O_NS = O_CS + 8388608, O_MS = O_NS + 65536, O_CONVS = O_MS + 512, O_END = O_CONVS + 1441792;
static_assert(O_END == 32272928, "output size");
constexpr size_t WS_CTL = 0, CTL_ZERO_BYTES = 1u << 20;
constexpr size_t WS_WIN = CTL_ZERO_BYTES, WS_WOA = WS_WIN + (size_t)N1 * D * 2, WS_WOM = WS_WOA + (size_t)D * QAW * 2, WS_WOUT = WS_WOM + (size_t)D * DMW * 2, WS_WUP = WS_WOUT + (size_t)D * D * 2,
                 WS_WDN = WS_WUP + (size_t)F2 * D * 2, WS_WPLE = WS_WDN + (size_t)D * DFF * 2, WS_WG = WS_WPLE + (size_t)D * PLE * 2;
constexpr size_t WS_BUFA = WS_WG + (size_t)D * D * 2;
constexpr size_t WS_PB = WS_BUFA + (size_t)M * D * 2;
constexpr size_t WS_IG = WS_PB + (size_t)M * PLE * 2, WS_LF = WS_IG + (size_t)M * 16, WS_SS = WS_LF + (size_t)M * 16;
constexpr size_t WS_Z = WS_SS + (size_t)M * 64;
constexpr size_t ZS512 = (size_t)M * 512 * 2, ZS128 = (size_t)M * 128 * 2, ZS1024 = (size_t)M * 1024 * 2;
constexpr size_t Z_QA = 0, Z_KA = Z_QA + ZS512, Z_VA = Z_KA + ZS128, Z_QM = Z_VA + ZS128, Z_KM = Z_QM + ZS512, Z_VM = Z_KM + ZS512, Z_OM = Z_VM + ZS512, Z_GA = Z_OM + ZS512, Z_GM = Z_GA + ZS1024, Z_END = Z_GM + ZS1024;
constexpr size_t WS_END = WS_Z + Z_END;
constexpr size_t Z_MIXED = Z_KM, Z_ACT = Z_QA, Z_TPLE = Z_GA, Z_UB = Z_GM;
static_assert(Z_GA - Z_QA == (size_t)M * DFF * 2, "ACT overlay fits exactly");
static_assert((size_t)(MP / 64) * 4 * F2 * 4 <= ZS1024, "UB fits in GM");
static_assert(WS_END <= (size_t)256 << 20, "workspace");
constexpr size_t MS_DC = 0, MS_DN = (size_t)256 * 16384 * 4, MS_DS = MS_DN + (size_t)256 * 128 * 4;
static_assert(MS_DS + 256 * 8 <= (size_t)M * D * 2, "mLSTM scratch fits in BUFA");

namespace ep {
using pg8::f32x4; using pg8::u32x4; using pg8::bf16_t; using pg8::Unit; using pg8::BM; using pg8::HALF;
typedef unsigned u32x2 __attribute__((ext_vector_type(2)));
typedef float f32x2_t __attribute__((ext_vector_type(2))); typedef __bf16 bf16x2_t __attribute__((ext_vector_type(2)));
__device__ __forceinline__ unsigned pk2(float lo, float hi) { f32x2_t v = {lo, hi}; bf16x2_t b = __builtin_convertvector(v, bf16x2_t); return __builtin_bit_cast(unsigned, b); }
__device__ __forceinline__ float lo16(unsigned w) { return __uint_as_float(w << 16); }
__device__ __forceinline__ float hi16(unsigned w) { return __uint_as_float(w & 0xffff0000u); }
__device__ __forceinline__ f32x4 unpk4(u32x2 w) { return (f32x4){lo16(w.x), hi16(w.x), lo16(w.y), hi16(w.y)}; }
__device__ __forceinline__ u32x2 pk4(f32x4 v) { return (u32x2){pk2(v[0], v[1]), pk2(v[2], v[3])}; }
__device__ __forceinline__ float sigm(float x) { return __builtin_amdgcn_rcpf(1.0f + __builtin_amdgcn_exp2f(-LOG2E * x)); }
__device__ __forceinline__ f32x4 sigm4(f32x4 v) { return (f32x4){sigm(v[0]), sigm(v[1]), sigm(v[2]), sigm(v[3])}; }
__device__ __forceinline__ float gelu_t(float x) { const float z2 = x * (1.0f + 0.044715f * x * x) * (2.0f * 0.7978845608028654f * LOG2E); return x * __builtin_amdgcn_rcpf(1.0f + __builtin_amdgcn_exp2f(-z2)); }

struct EpiZ {
    static constexpr bool PERM = true, AFTER_DRAIN = false;
    unsigned char* z;
    __device__ __forceinline__ void operator()(const f32x4 (&acc)[2][2][4][2], const Unit& u, int wr, int wc, int fr, int fq) const {
        const int pn = u.pn; bf16_t* p0; bf16_t* p1; int ld; int op = 0;
        if (pn < 2)       { ld = 512; p0 = (bf16_t*)(z + Z_QA) + 256 * pn; p1 = p0 + 128; }
        else if (pn == 2) { ld = 128; p0 = (bf16_t*)(z + Z_KA); p1 = (bf16_t*)(z + Z_VA); }
        else if (pn < 11) { const int t = (pn - 3) >> 1, hs = (pn - 3) & 1; ld = 512; p0 = (bf16_t*)(z + Z_QM + (size_t)t * ZS512) + 256 * hs; p1 = p0 + 128; op = (t == 3) ? 2 : ((t == 1) ? 1 : 0); }
        else              { const int t = (pn - 11) >> 2, q = (pn - 11) & 3; ld = 1024; p0 = (bf16_t*)(z + Z_GA + (size_t)t * ZS1024) + 256 * q; p1 = p0 + 128; op = 2; }
        const int row0 = u.pm * BM + wr * 64 + fr, cw = wc * 32 + 8 * fq;
#pragma unroll
        for (int ai = 0; ai < 2; ++ai)
#pragma unroll
            for (int m = 0; m < 4; ++m) { const size_t ro = (size_t)(row0 + ai * HALF + m * 16) * ld + cw;
#pragma unroll
                for (int bj = 0; bj < 2; ++bj) { f32x4 v0 = acc[ai][bj][m][0], v1 = acc[ai][bj][m][1];
                    if (op == 1) { v0 = v0 * 0.08838834764831845f; v1 = v1 * 0.08838834764831845f; }
                    else if (op == 2) { v0 = sigm4(v0); v1 = sigm4(v1); }
                    u32x4 w; w.x = pk2(v0[0], v0[1]); w.y = pk2(v0[2], v0[3]); w.z = pk2(v1[0], v1[1]); w.w = pk2(v1[2], v1[3]);
                    *(u32x4*)((bj ? p1 : p0) + ro) = w; } }
    }
};
template <int MODE> struct EpiMix {
    static constexpr bool PERM = true, AFTER_DRAIN = false;
    const bf16_t* gate; bf16_t* out;
    __device__ __forceinline__ void operator()(const f32x4 (&acc)[2][2][4][2], const Unit& u, int wr, int wc, int fr, int fq) const {
        const int row0 = u.pm * BM + wr * 64 + fr, col0 = u.pn * BM + wc * 32 + 8 * fq;
#pragma unroll
        for (int ai = 0; ai < 2; ++ai)
#pragma unroll
            for (int m = 0; m < 4; ++m)
#pragma unroll
                for (int bj = 0; bj < 2; ++bj) { const size_t off = (size_t)(row0 + ai * HALF + m * 16) * D + col0 + bj * HALF;
                    const u32x4 g = *(const u32x4*)(gate + off); f32x4 v0 = acc[ai][bj][m][0], v1 = acc[ai][bj][m][1];
                    v0 = v0 * (f32x4){lo16(g.x), hi16(g.x), lo16(g.y), hi16(g.y)}; v1 = v1 * (f32x4){lo16(g.z), hi16(g.z), lo16(g.w), hi16(g.w)};
                    if (MODE == 1) { const u32x4 t = *(const u32x4*)(out + off); v0 = v0 + (f32x4){lo16(t.x), hi16(t.x), lo16(t.y), hi16(t.y)}; v1 = v1 + (f32x4){lo16(t.z), hi16(t.z), lo16(t.w), hi16(t.w)}; }
                    u32x4 w; w.x = pk2(v0[0], v0[1]); w.y = pk2(v0[2], v0[3]); w.z = pk2(v1[0], v1[1]); w.w = pk2(v1[2], v1[3]);
                    *(u32x4*)(out + off) = w; }
    }
};
struct EpiX1 {
    static constexpr bool PERM = false, AFTER_DRAIN = false;
    const float* xp; const float* xs; float* x1; bf16_t* x1b; float* ss;
    __device__ __forceinline__ void operator()(const f32x4 (&acc)[2][2][4][2], const Unit& u, int wr, int wc, int fr, int fq) const {
        const int row0 = u.pm * BM + wr * 64 + fr, col0 = u.pn * BM + wc * 32 + 4 * fq;
#pragma unroll
        for (int ai = 0; ai < 2; ++ai)
#pragma unroll
            for (int m = 0; m < 4; ++m) { const int row = row0 + ai * HALF + m * 16; const float* xr = (row < MP) ? xp + (size_t)row * D : xs + (size_t)(row - MP) * D; float q = 0.f;
#pragma unroll
                for (int bj = 0; bj < 2; ++bj)
#pragma unroll
                    for (int n = 0; n < 2; ++n) { const int col = col0 + bj * HALF + n * 16; const f32x4 v = *(const f32x4*)(xr + col) + acc[ai][bj][m][n];
                        *(f32x4*)(x1 + (size_t)row * D + col) = v; *(u32x2*)(x1b + (size_t)row * D + col) = pk4(v); q += (v[0] * v[0] + v[1] * v[1]) + (v[2] * v[2] + v[3] * v[3]); }
                q += __shfl_xor(q, 16); q += __shfl_xor(q, 32);
                if (fq == 0) ss[(size_t)row * 16 + u.pn * 4 + wc] = q; }
    }
};
struct EpiX2 {
    static constexpr bool PERM = false, AFTER_DRAIN = false;
    float* xio; bf16_t* x2b;
    __device__ __forceinline__ void operator()(const f32x4 (&acc)[2][2][4][2], const Unit& u, int wr, int wc, int fr, int fq) const {
        const int row0 = u.pm * BM + wr * 64 + fr, col0 = u.pn * BM + wc * 32 + 4 * fq;
#pragma unroll
        for (int ai = 0; ai < 2; ++ai)
#pragma unroll
            for (int m = 0; m < 4; ++m)
#pragma unroll
                for (int bj = 0; bj < 2; ++bj)
#pragma unroll
                    for (int n = 0; n < 2; ++n) { const size_t off = (size_t)(row0 + ai * HALF + m * 16) * D + col0 + bj * HALF + n * 16; const f32x4 v = *(const f32x4*)(xio + off) + acc[ai][bj][m][n];
                        *(f32x4*)(xio + off) = v; *(u32x2*)(x2b + off) = pk4(v); }
    }
};
struct EpiT {
    static constexpr bool PERM = false, AFTER_DRAIN = false;
    bf16_t* t;
    __device__ __forceinline__ void operator()(const f32x4 (&acc)[2][2][4][2], const Unit& u, int wr, int wc, int fr, int fq) const {
        const int row0 = u.pm * BM + wr * 64 + fr, col0 = u.pn * BM + wc * 32 + 4 * fq;
#pragma unroll
        for (int ai = 0; ai < 2; ++ai)
#pragma unroll
            for (int m = 0; m < 4; ++m)
#pragma unroll
                for (int bj = 0; bj < 2; ++bj)
#pragma unroll
                    for (int n = 0; n < 2; ++n) { const size_t off = (size_t)(row0 + ai * HALF + m * 16) * D + col0 + bj * HALF + n * 16; *(u32x2*)(t + off) = pk4(acc[ai][bj][m][n]); }
    }
};
struct EpiY {
    static constexpr bool PERM = false, AFTER_DRAIN = false;
    float* xio; const bf16_t* t;
    __device__ __forceinline__ void operator()(const f32x4 (&acc)[2][2][4][2], const Unit& u, int wr, int wc, int fr, int fq) const {
        const int row0 = u.pm * BM + wr * 64 + fr, col0 = u.pn * BM + wc * 32 + 4 * fq;
#pragma unroll
        for (int ai = 0; ai < 2; ++ai)
#pragma unroll
            for (int m = 0; m < 4; ++m)
#pragma unroll
                for (int bj = 0; bj < 2; ++bj)
#pragma unroll
                    for (int n = 0; n < 2; ++n) { const size_t off = (size_t)(row0 + ai * HALF + m * 16) * D + col0 + bj * HALF + n * 16;
                        const f32x4 tv = unpk4(*(const u32x2*)(t + off)); const f32x4 v = *(const f32x4*)(xio + off) + sigm4(acc[ai][bj][m][n]) * tv; *(f32x4*)(xio + off) = v; }
    }
};
struct EpiConv {
    static constexpr bool PERM = true, AFTER_DRAIN = false;
    const float* ss; const float* cw; const float* cb; const float* st; bf16_t* act; float* ub; float* cso;
    __device__ __forceinline__ void operator()(f32x4 (&acc)[2][2][4][2], const Unit& u, int wr, int wc, int fr, int fq) const {
        const bool sample = u.pm >= MP / BM;
        const int row0 = u.pm * BM + wr * 64 + fr;
        float rs[2][4];
#pragma unroll
        for (int ai = 0; ai < 2; ++ai)
#pragma unroll
            for (int m = 0; m < 4; ++m) { const f32x4 a = *(const f32x4*)(ss + (size_t)(row0 + ai * HALF + m * 16) * 16 + 4 * fq);
                float q = (a[0] + a[1]) + (a[2] + a[3]); q += __shfl_xor(q, 16); q += __shfl_xor(q, 32);
                rs[ai][m] = 1.0f / sqrtf(q * (1.0f / D) + EPS); }
        const int lane16 = (int)(threadIdx.x & 63) & ~15;
        const int src1 = lane16 | ((fr - 1) & 15), src2 = lane16 | ((fr - 2) & 15);
#pragma unroll
        for (int n = 0; n < 2; ++n) {
            const int ja = u.pn * 128 + wc * 32 + 8 * fq + 4 * n;
#pragma unroll
            for (int hb = 1; hb >= 0; --hb) {
                const int uc = hb * DFF + ja;
                const f32x4 w0 = *(const f32x4*)(cw + uc), w1 = *(const f32x4*)(cw + F2 + uc), w2 = *(const f32x4*)(cw + 2 * F2 + uc), bb = *(const f32x4*)(cb + uc);
#pragma unroll
                for (int ai = 0; ai < 2; ++ai) {
                    f32x4 pv = (f32x4){0.f, 0.f, 0.f, 0.f};
#pragma unroll
                    for (int m = 0; m < 4; ++m) {
                        const int row = row0 + ai * HALF + m * 16;
                        const f32x4 uv = acc[ai][hb][m][n] * rs[ai][m];
                        f32x4 y;
                        if (!sample) {
#pragma unroll
                            for (int e = 0; e < 4; ++e) { const float x1 = __shfl((fr == 15) ? pv[e] : uv[e], src1), x2 = __shfl((fr >= 14) ? pv[e] : uv[e], src2);
                                y[e] = bb[e] + w0[e] * x2 + w1[e] * x1 + w2[e] * uv[e]; }
                            int k = -1; if (m == 0 && fr < 2) k = fr; if (m == 3 && fr >= 14) k = fr - 12;
                            if (k >= 0) *(f32x4*)(ub + ((size_t)(row >> 6) * 4 + k) * F2 + uc) = uv;
                        } else {
                            const int t = fr & 3, sq = (row - MP) >> 2;
                            const f32x4 s0 = *(const f32x4*)(st + (size_t)(sq * 2 + 0) * F2 + uc), s1 = *(const f32x4*)(st + (size_t)(sq * 2 + 1) * F2 + uc);
#pragma unroll
                            for (int e = 0; e < 4; ++e) { const float r1 = __shfl(uv[e], src1), r2 = __shfl(uv[e], src2);
                                const float x1 = (t >= 1) ? r1 : s1[e], x2 = (t >= 2) ? r2 : ((t == 1) ? s1[e] : s0[e]);
                                y[e] = bb[e] + w0[e] * x2 + w1[e] * x1 + w2[e] * uv[e]; }
                            if (t >= 2) *(f32x4*)(cso + (size_t)(sq * 2 + (t - 2)) * F2 + uc) = uv;
                        }
                        if (hb == 1) acc[ai][1][m][n] = y;
                        else { const f32x4 yb = acc[ai][1][m][n]; const f32x4 r = (f32x4){gelu_t(y[0]) * yb[0], gelu_t(y[1]) * yb[1], gelu_t(y[2]) * yb[2], gelu_t(y[3]) * yb[3]};
                            if (sample || m != 0 || fr >= 2) *(u32x2*)(act + (size_t)row * DFF + ja) = pk4(r); }
                        pv = uv;
                    }
                }
            }
        }
    }
};
}
#define GAS __attribute__((address_space(1)))
#define LAS __attribute__((address_space(3)))
typedef unsigned short bf16;
typedef unsigned v4u __attribute__((ext_vector_type(4)));
typedef float f32x4 __attribute__((ext_vector_type(4)));
typedef short bf16x8 __attribute__((ext_vector_type(8)));
typedef GAS unsigned gu32;
typedef GAS unsigned long long gu64;
#define RLX_AGENT __ATOMIC_RELAXED, __HIP_MEMORY_SCOPE_AGENT
#define LDS_WAIT() asm volatile("s_waitcnt lgkmcnt(0)" ::: "memory")
#define VM_WAIT() asm volatile("s_waitcnt vmcnt(0)" ::: "memory")
__device__ __forceinline__ unsigned long long rt() { return __builtin_amdgcn_s_memrealtime(); }

#define XB_TMO      128
#define XB_XCNT(j)  (256  + 64 * (j))
#define XB_XSUB(j)  (1280 + 64 * (j))
#define XB_XGEN(j)  (2304 + 64 * (j))
#define XB_TOP      3328
#define XB_TOPGEN   3392
#define XCD_BAR_WORDS 3456
#define XB_SPIN_CAP (1u << 18)

__device__ __forceinline__ unsigned xb_ld(unsigned* p)              { return __hip_atomic_load(p, __ATOMIC_RELAXED, __HIP_MEMORY_SCOPE_AGENT); }
__device__ __forceinline__ unsigned xb_add(unsigned* p, unsigned v) { return __hip_atomic_fetch_add(p, v, __ATOMIC_RELAXED, __HIP_MEMORY_SCOPE_AGENT); }
__device__ __forceinline__ unsigned xb_xcc_id() { return (unsigned)__builtin_amdgcn_s_getreg((3 << 11) | 20) & 0xFu; }
#define XB_SPIN(cond, bar) do { unsigned _sp = 0; while (cond) { __builtin_amdgcn_s_sleep(1); \
    if ((++_sp & 255u) == 0u) { if (xb_ld(&(bar)[XB_TMO])) break; if (_sp > XB_SPIN_CAP) { atomicAdd(&(bar)[XB_TMO], 1u); break; } } } } while (0)

struct XcdBarrier {
    unsigned* bar; unsigned x;
    volatile LAS unsigned* st;
};

__device__ __forceinline__ XcdBarrier xcd_barrier_post(unsigned* bar, volatile LAS unsigned* st) {
    XcdBarrier b; b.bar = bar; b.x = xb_xcc_id(); b.st = st;
    if (threadIdx.x == 0) (void)xb_add(&bar[XB_XCNT(b.x)], 1u);
    return b;
}
__device__ __forceinline__ void xcd_barrier_complete(unsigned* bar, unsigned x, unsigned& nloc, unsigned& nx) {
    const unsigned G = gridDim.x * gridDim.y * gridDim.z;
    unsigned sum, cnt, mine, sp = 0u;
    for (;;) {
        sum = 0u; cnt = 0u; mine = 0u;
#pragma unroll
        for (unsigned j = 0; j < 16; ++j) { const unsigned c = xb_ld(&bar[XB_XCNT(j)]); sum += c; cnt += (c > 0u) ? 1u : 0u; mine = (j == x) ? c : mine; }
        if (sum == G) break;
        __builtin_amdgcn_s_sleep(1);
        if ((++sp & 255u) == 0u) { if (xb_ld(&bar[XB_TMO])) break; if (sp > XB_SPIN_CAP) { atomicAdd(&bar[XB_TMO], 1u); break; } }
    }
    nloc = mine > 0u ? mine : 1u; nx = cnt > 0u ? cnt : 1u;
}

__device__ __forceinline__ void xcd_barrier(const XcdBarrier& b) {
    asm volatile("s_waitcnt vmcnt(0)" ::: "memory");
    __syncthreads();
    if (threadIdx.x == 0) {
        unsigned* bar = b.bar;
        __builtin_amdgcn_s_waitcnt(0);
        unsigned nloc = b.st[0], nx = b.st[1];
        if (nloc == 0u) { xcd_barrier_complete(bar, b.x, nloc, nx); b.st[0] = nloc; b.st[1] = nx; }
        const unsigned old = xb_add(&bar[XB_XSUB(b.x)], 1u);
        const unsigned gen = old / nloc;
        if (old + 1u == (gen + 1u) * nloc) {
            __builtin_amdgcn_fence(__ATOMIC_RELEASE, "agent");
            asm volatile("s_waitcnt vmcnt(0)" ::: "memory");
            const unsigned og = xb_add(&bar[XB_TOP], 1u);
            const unsigned tg = og / nx;
            if (og + 1u == (tg + 1u) * nx) xb_add(&bar[XB_TOPGEN], 1u);
            else XB_SPIN(xb_ld(&bar[XB_TOPGEN]) == tg, bar);
            __builtin_amdgcn_fence(__ATOMIC_ACQUIRE, "agent");
            xb_add(&bar[XB_XGEN(b.x)], 1u);
            asm volatile("s_waitcnt vmcnt(0)" ::: "memory");
        } else {
            XB_SPIN(xb_ld(&bar[XB_XGEN(b.x)]) == gen, bar);
            __builtin_amdgcn_fence(__ATOMIC_ACQUIRE, "agent");
            asm volatile("s_waitcnt vmcnt(0)" ::: "memory");
        }
    }
    __syncthreads();
}

constexpr int NWAVES = 8;
constexpr int RING_OFF = 0, RING_BYTES = 131072;
constexpr int LDSCTL_OFF = RING_BYTES, MISC_OFF = LDSCTL_OFF + 320;
constexpr int LDS_BYTES = 147456;
constexpr int CW_TMO = 0, CW_BAR = 4096;
typedef short s16x4 __attribute__((ext_vector_type(4)));
typedef float f32x16 __attribute__((ext_vector_type(16)));
typedef unsigned u32x2 __attribute__((ext_vector_type(2)));
typedef short v4i16_t __attribute__((ext_vector_type(4)));
#define DI __device__ __forceinline__
using ep::pk2; using ep::lo16; using ep::hi16; using ep::sigm;

struct Frame {
    LAS unsigned char* lds;
    volatile LAS unsigned* MISC;
    gu32* ctl;
    int tid, lane, wave, G, bid;
    const float* in[28]; float* out; unsigned char* ws;
};
DI float wave_sum(float v) {
#pragma unroll
    for (int o = 1; o < 64; o <<= 1) v += __shfl_xor(v, o);
    return v;
}
DI void unpack8(v4u w, float (&f)[8]) { f[0] = lo16(w.x); f[1] = hi16(w.x); f[2] = lo16(w.y); f[3] = hi16(w.y); f[4] = lo16(w.z); f[5] = hi16(w.z); f[6] = lo16(w.w); f[7] = hi16(w.w); }
DI v4u pack8(const float (&f)[8]) { v4u w; w.x = pk2(f[0], f[1]); w.y = pk2(f[2], f[3]); w.z = pk2(f[4], f[5]); w.w = pk2(f[6], f[7]); return w; }
DI f32x16 mfma32(bf16x8 a, bf16x8 b, f32x16 c) { return __builtin_amdgcn_mfma_f32_32x32x16_bf16(a, b, c, 0, 0, 0); }
DI s16x4 trd(const LAS bf16* p) { return __builtin_bit_cast(s16x4, __builtin_amdgcn_ds_read_tr16_b64_v4i16((LAS v4i16_t*)p)); }
DI int crow(int reg, int h) { return (reg & 3) + 8 * (reg >> 2) + 4 * h; }
DI bf16x8 cat8(s16x4 lo, s16x4 hi) { return __builtin_shufflevector(lo, hi, 0, 1, 2, 3, 4, 5, 6, 7); }
DI bf16x8 frag_t(const LAS bf16* X, int ld, int k0, int n0, int lane) {
    const int g = lane >> 4, q = (lane & 15) >> 2, p = lane & 3;
    const LAS bf16* a = X + (k0 + 8 * (g >> 1) + q) * ld + n0 + 16 * (g & 1) + 4 * p;
    return cat8(trd(a), trd(a + 4 * ld));
}
DI bf16x8 frag_tp(const LAS bf16* X, int ld, int k0, int n0, int lane) {
    const int g = lane >> 4, q = (lane & 15) >> 2, p = lane & 3;
    const LAS bf16* a = X + (k0 + 4 * (g >> 1) + q) * ld + n0 + 16 * (g & 1) + 4 * p;
    return cat8(trd(a), trd(a + 8 * ld));
}
DI bf16x8 packacc(const f32x16& x, int s) {
    v4u w; w.x = pk2(x[8 * s + 0], x[8 * s + 1]); w.y = pk2(x[8 * s + 2], x[8 * s + 3]); w.z = pk2(x[8 * s + 4], x[8 * s + 5]); w.w = pk2(x[8 * s + 6], x[8 * s + 7]);
    return __builtin_bit_cast(bf16x8, w);
}

DI void p0_transpose_item(const float* W, int ldw, int src_col0, int K, bf16* WT, int dst_row0, int k0, const float* kscale, LAS float* scr, int lane) {
#pragma unroll 8
    for (int i = 0; i < 32; ++i) { const int kk = 2 * i + (lane >> 5); float v = W[(size_t)(k0 + kk) * ldw + src_col0 + (lane & 31)]; if (kscale) v *= kscale[k0 + kk]; scr[kk * 33 + (lane & 31)] = v; }
    LDS_WAIT(); asm volatile("" ::: "memory");
    const int c = lane & 7;
#pragma unroll
    for (int j = 0; j < 4; ++j) { const int n = (lane >> 3) + 8 * j; const LAS float* s = scr + (8 * c) * 33 + n;
        v4u o; o.x = pk2(s[0 * 33], s[1 * 33]); o.y = pk2(s[2 * 33], s[3 * 33]); o.z = pk2(s[4 * 33], s[5 * 33]); o.w = pk2(s[6 * 33], s[7 * 33]);
        *(GAS v4u*)(WT + (size_t)(dst_row0 + n) * K + k0 + 8 * c) = o; }
    LDS_WAIT(); asm volatile("" ::: "memory");
}
DI void p0_prologue(Frame& F) {
    const int gw = F.bid * NWAVES + F.wave, NGW = F.G * NWAVES, lane = F.lane;
    unsigned char* ws = F.ws;
    {
        LAS float* scr = (LAS float*)(F.lds + RING_OFF + F.wave * 8704);
        constexpr int I_IN = 16 * (N1 / 32), I_OA = 8 * 32, I_OUT = 16 * 32, I_UP = 16 * (F2 / 32), I_DN = (DFF / 64) * 32, I_PLE = 4 * 32, I_G = 16 * 32;
        constexpr int NITEMS = I_IN + 2 * I_OA + I_OUT + I_UP + I_DN + I_PLE + I_G;
        for (int it = gw; it < NITEMS; it += NGW) {
            int r = it;
            if (r < I_IN) { const int nb = r % (N1 / 32), kb = r / (N1 / 32), n0 = nb * 32; p0_transpose_item(F.in[11], DIN, n0 < 2816 ? n0 : n0 + 8, D, (bf16*)(ws + WS_WIN), n0, kb * 64, nullptr, scr, lane); continue; } r -= I_IN;
            if (r < I_OA) { p0_transpose_item(F.in[18], D, (r % 32) * 32, QAW, (bf16*)(ws + WS_WOA), (r % 32) * 32, (r / 32) * 64, nullptr, scr, lane); continue; } r -= I_OA;
            if (r < I_OA) { p0_transpose_item(F.in[19], D, (r % 32) * 32, DMW, (bf16*)(ws + WS_WOM), (r % 32) * 32, (r / 32) * 64, nullptr, scr, lane); continue; } r -= I_OA;
            if (r < I_OUT) { p0_transpose_item(F.in[20], D, (r % 32) * 32, D, (bf16*)(ws + WS_WOUT), (r % 32) * 32, (r / 32) * 64, nullptr, scr, lane); continue; } r -= I_OUT;
            if (r < I_UP) { const int nb = r % (F2 / 32), kb = r / (F2 / 32), n0 = nb * 32, tile = n0 >> 8, within = n0 & 255;
                const int src = within < 128 ? tile * 128 + within : DFF + tile * 128 + (within - 128);
                p0_transpose_item(F.in[22], F2, src, D, (bf16*)(ws + WS_WUP), n0, kb * 64, F.in[21], scr, lane); continue; } r -= I_UP;
            if (r < I_DN) { p0_transpose_item(F.in[25], D, (r % 32) * 32, DFF, (bf16*)(ws + WS_WDN), (r % 32) * 32, (r / 32) * 64, nullptr, scr, lane); continue; } r -= I_DN;
            if (r < I_PLE) { p0_transpose_item(F.in[26], D, (r % 32) * 32, PLE, (bf16*)(ws + WS_WPLE), (r % 32) * 32, (r / 32) * 64, nullptr, scr, lane); continue; } r -= I_PLE;
            p0_transpose_item(F.in[27], D, (r % 32) * 32, D, (bf16*)(ws + WS_WG), (r % 32) * 32, (r / 32) * 64, nullptr, scr, lane);
        }
    }
    __syncthreads();
    LAS float* WGt = (LAS float*)(F.lds + RING_OFF);
    for (int i = F.tid; i < 8 * D; i += NWAVES * 64) { const int k = i >> 3, j = i & 7; WGt[j * D + k] = F.in[11][(size_t)k * DIN + 2816 + j]; }
    __syncthreads();
    f32x4 g4[4];
#pragma unroll
    for (int j = 0; j < 4; ++j) g4[j] = ((const GAS f32x4*)F.in[10])[lane + 64 * j];
    bf16* XN = (bf16*)(ws + WS_BUFA); float* IG = (float*)(ws + WS_IG); float* LF = (float*)(ws + WS_LF); bf16* PB = (bf16*)(ws + WS_PB);
    for (int m = gw; m < M; m += NGW) {
        const float* xrow = (m < MP) ? F.in[0] + (size_t)m * D : F.in[1] + (size_t)(m - MP) * D;
        const GAS f32x4* xr = (const GAS f32x4*)xrow + lane;
        f32x4 v[4]; float s2 = 0.f;
#pragma unroll
        for (int j = 0; j < 4; ++j) { v[j] = xr[64 * j]; s2 += (v[j].x * v[j].x + v[j].y * v[j].y) + (v[j].z * v[j].z + v[j].w * v[j].w); }
        const float rstd = 1.0f / sqrtf(wave_sum(s2) * (1.0f / D) + EPS);
        float gd[8];
#pragma unroll
        for (int c = 0; c < 8; ++c) gd[c] = 0.f;
        GAS unsigned long long* o8 = (GAS unsigned long long*)(XN + (size_t)m * D) + lane;
#pragma unroll
        for (int j = 0; j < 4; ++j) { const f32x4 xn = v[j] * g4[j] * rstd;
            o8[64 * j] = (unsigned long long)pk2(xn.x, xn.y) | ((unsigned long long)pk2(xn.z, xn.w) << 32);
#pragma unroll
            for (int c = 0; c < 8; ++c) { const f32x4 w = *(const LAS f32x4*)(WGt + c * D + 4 * lane + 256 * j); gd[c] += (xn.x * w.x + xn.y * w.y) + (xn.z * w.z + xn.w * w.w); } }
#pragma unroll
        for (int c = 0; c < 8; ++c) gd[c] = wave_sum(gd[c]);
        if (lane < 4) { float gi = gd[0], gf = gd[4];
            if (lane == 1) { gi = gd[1]; gf = gd[5]; } else if (lane == 2) { gi = gd[2]; gf = gd[6]; } else if (lane == 3) { gi = gd[3]; gf = gd[7]; }
            IG[(size_t)m * 4 + lane] = gi + F.in[12][lane];
            const float xf = gf + F.in[13][lane];
            LF[(size_t)m * 4 + lane] = fminf(xf, 0.f) - log1pf(expf(-fabsf(xf))); }
        const float* prow = (m < MP) ? F.in[8] + (size_t)m * PLE : F.in[9] + (size_t)(m - MP) * PLE;
        const f32x4 pv = ((const GAS f32x4*)prow)[lane];
        ((GAS unsigned long long*)(PB + (size_t)m * PLE))[lane] = (unsigned long long)pk2(pv.x, pv.y) | ((unsigned long long)pk2(pv.z, pv.w) << 32);
    }
    __syncthreads();
}

constexpr int LDA = 72;
constexpr int LDM = 136;
constexpr int SC_OFF = 0, GQ_OFF = 5120, T0_OFF = 6144;

DI void attn_chunk(const LAS bf16* Ks, const LAS bf16* Vs, int kb0, const bf16x8 (&qf)[4], int ioff, int jkmin, float slope2, float sink2, int lane, f32x16 (&ot)[2], float& inv) {
    const int r = lane & 31, h = lane >> 5;
    f32x16 st[5];
#pragma unroll
    for (int kb = 0; kb < 5; ++kb) {
#pragma unroll
        for (int i = 0; i < 16; ++i) st[kb][i] = 0.f;
#pragma unroll
        for (int ks = 0; ks < 4; ++ks) { const bf16x8 a = *(const LAS bf16x8*)(Ks + (32 * (kb0 + kb) + r) * LDA + 16 * ks + 8 * h); st[kb] = mfma32(a, qf[ks], st[kb]); }
    }
    float mx = sink2;
#pragma unroll
    for (int kb = 0; kb < 5; ++kb)
#pragma unroll
        for (int i = 0; i < 16; ++i) { const int jk = 32 * (kb0 + kb) + crow(i, h), rel = jk - ioff; const bool valid = (rel >= 0) && (rel <= WIN) && (jk >= jkmin);
            const float s = valid ? st[kb][i] - slope2 * (float)(WIN - rel) : -INFINITY; st[kb][i] = s; mx = fmaxf(mx, s); }
    mx = fmaxf(mx, __shfl_xor(mx, 32));
    float sum = 0.f;
#pragma unroll
    for (int kb = 0; kb < 5; ++kb)
#pragma unroll
        for (int i = 0; i < 16; ++i) { const float e = __builtin_amdgcn_exp2f(st[kb][i] - mx); st[kb][i] = e; sum += e; }
    sum += __shfl_xor(sum, 32); sum += __builtin_amdgcn_exp2f(sink2 - mx);
    inv = 1.0f / sum;
#pragma unroll
    for (int db = 0; db < 2; ++db)
#pragma unroll
        for (int i = 0; i < 16; ++i) ot[db][i] = 0.f;
#pragma unroll
    for (int kb = 0; kb < 5; ++kb)
#pragma unroll
        for (int s = 0; s < 2; ++s) { const bf16x8 pf = packacc(st[kb], s);
#pragma unroll
            for (int db = 0; db < 2; ++db) { const bf16x8 vf = frag_tp(Vs, LDA, 32 * (kb0 + kb) + 16 * s, 32 * db, lane); ot[db] = mfma32(vf, pf, ot[db]); } }
}
DI void q_prep(const bf16* qp, const LAS float* gq, int lane, bf16x8 (&qf)[4]) {
    const int h = lane >> 5; float f[4][8]; float s2 = 0.f;
#pragma unroll
    for (int ks = 0; ks < 4; ++ks) { const v4u w = *(const GAS v4u*)(qp + 16 * ks + 8 * h); unpack8(w, f[ks]);
#pragma unroll
        for (int j = 0; j < 8; ++j) s2 += f[ks][j] * f[ks][j]; }
    s2 += __shfl_xor(s2, 32);
    const float sc = (0.125f * LOG2E) / sqrtf(s2 * (1.0f / HDA) + EPS);
#pragma unroll
    for (int ks = 0; ks < 4; ++ks) { float o[8];
#pragma unroll
        for (int j = 0; j < 8; ++j) o[j] = f[ks][j] * sc * gq[16 * ks + 8 * h + j];
        qf[ks] = __builtin_bit_cast(bf16x8, pack8(o)); }
}
DI void attn_store(bf16* op, const f32x16 (&ot)[2], float inv, int h) {
#pragma unroll
    for (int db = 0; db < 2; ++db)
#pragma unroll
        for (int i4 = 0; i4 < 4; ++i4) { u32x2 w; w.x = pk2(ot[db][4 * i4] * inv, ot[db][4 * i4 + 1] * inv); w.y = pk2(ot[db][4 * i4 + 2] * inv, ot[db][4 * i4 + 3] * inv);
            *(GAS u32x2*)(op + 32 * db + 8 * i4 + 4 * h) = w; }
}
DI void attn_prompt_unit(Frame& F, int ui) {
    const int b = ui >> 5, jb = (ui >> 1) & 15, kvh = ui & 1, tid = F.tid, lane = F.lane;
    unsigned char* z = F.ws + WS_Z;
    bf16* QA = (bf16*)(z + Z_QA); const bf16* KA = (const bf16*)(z + Z_KA); const bf16* VA = (const bf16*)(z + Z_VA);
    LAS bf16* Ks = (LAS bf16*)(F.lds + T0_OFF); LAS bf16* Vs = Ks + 256 * LDA;
    const LAS float* gq = (const LAS float*)(F.lds + GQ_OFF); const LAS float* gk = gq + 64;
#pragma unroll
    for (int i = 0; i < 4; ++i) { const int idx = tid + 512 * i, row = idx >> 3, ch = idx & 7, tok = 128 * (jb - 1) + row;
        v4u kw = (v4u){0u, 0u, 0u, 0u}, vw = kw;
        if (tok >= 0) { const size_t go = (size_t)(b * SEQ + tok) * KVW + kvh * HDA + 8 * ch; kw = *(const GAS v4u*)(KA + go); vw = *(const GAS v4u*)(VA + go); }
        float kf[8]; unpack8(kw, kf); float s2 = 0.f;
#pragma unroll
        for (int j = 0; j < 8; ++j) s2 += kf[j] * kf[j];
        s2 += __shfl_xor(s2, 1); s2 += __shfl_xor(s2, 2); s2 += __shfl_xor(s2, 4);
        const float rstd = 1.0f / sqrtf(s2 * (1.0f / HDA) + EPS);
#pragma unroll
        for (int j = 0; j < 8; ++j) kf[j] = kf[j] * rstd * gk[8 * ch + j];
        *(LAS v4u*)(Ks + row * LDA + 8 * ch) = pack8(kf); *(LAS v4u*)(Vs + row * LDA + 8 * ch) = vw;
        if (jb == 15 && row >= 128) { const size_t oo = ((size_t)(b * WIN + row - 128) * 2 + kvh) * HDA + 8 * ch; float vf[8]; unpack8(vw, vf);
            *(GAS f32x4*)(F.out + O_WKP + oo) = (f32x4){kf[0], kf[1], kf[2], kf[3]}; *(GAS f32x4*)(F.out + O_WKP + oo + 4) = (f32x4){kf[4], kf[5], kf[6], kf[7]};
            *(GAS f32x4*)(F.out + O_WVP + oo) = (f32x4){vf[0], vf[1], vf[2], vf[3]}; *(GAS f32x4*)(F.out + O_WVP + oo + 4) = (f32x4){vf[4], vf[5], vf[6], vf[7]}; }
    }
    __syncthreads();
    const int r = lane & 31, h = lane >> 5;
#pragma unroll 1
    for (int i = 0; i < 2; ++i) { const int pi = F.wave * 2 + i, g = pi >> 2, c = pi & 3, head = kvh * 4 + g;
        bf16* qp = QA + (size_t)(b * SEQ + 128 * jb + 32 * c + r) * QAW + head * HDA;
        bf16x8 qf[4]; q_prep(qp, gq, lane, qf);
        const float slope2 = exp2f(-(float)(head + 1)) * LOG2E, sink2 = F.in[16][head] * LOG2E;
        f32x16 ot[2]; float inv;
        attn_chunk(Ks, Vs, c, qf, 32 * c + r, jb == 0 ? 128 : 0, slope2, sink2, lane, ot, inv);
        attn_store(qp, ot, inv, h);
    }
    __syncthreads();
}
DI void attn_sample_unit(Frame& F, int ui) {
    const int db = ui >> 1, kvh = ui & 1, tid = F.tid, lane = F.lane;
    unsigned char* z = F.ws + WS_Z;
    bf16* QA = (bf16*)(z + Z_QA); const bf16* KA = (const bf16*)(z + Z_KA); const bf16* VA = (const bf16*)(z + Z_VA);
    LAS bf16* Ks = (LAS bf16*)(F.lds + T0_OFF); LAS bf16* Vs = Ks + 256 * LDA;
    const LAS float* gq = (const LAS float*)(F.lds + GQ_OFF); const LAS float* gk = gq + 64;
    const float* ck = F.in[2]; const float* cv = F.in[3];
#pragma unroll
    for (int i = 0; i < 4; ++i) { const int idx = tid + 512 * i, row = idx >> 4, c4 = idx & 15; const size_t so = ((size_t)(db * WIN + row) * 2 + kvh) * HDA + 4 * c4;
        const f32x4 kv = *(const GAS f32x4*)(ck + so), vv = *(const GAS f32x4*)(cv + so);
        *(LAS u32x2*)(Ks + row * LDA + 4 * c4) = (u32x2){pk2(kv.x, kv.y), pk2(kv.z, kv.w)}; *(LAS u32x2*)(Vs + row * LDA + 4 * c4) = (u32x2){pk2(vv.x, vv.y), pk2(vv.z, vv.w)};
        if (row >= DSEQ) { const size_t oo = ((size_t)(db * WIN + row - DSEQ) * 2 + kvh) * HDA + 4 * c4; *(GAS f32x4*)(F.out + O_WKS + oo) = kv; *(GAS f32x4*)(F.out + O_WVS + oo) = vv; } }
    if (tid < 32) { const int t = tid >> 3, ch = tid & 7; const size_t go = (size_t)(MP + db * DSEQ + t) * KVW + kvh * HDA + 8 * ch;
        const v4u kw = *(const GAS v4u*)(KA + go), vw = *(const GAS v4u*)(VA + go);
        float kf[8]; unpack8(kw, kf); float s2 = 0.f;
#pragma unroll
        for (int j = 0; j < 8; ++j) s2 += kf[j] * kf[j];
        s2 += __shfl_xor(s2, 1); s2 += __shfl_xor(s2, 2); s2 += __shfl_xor(s2, 4);
        const float rstd = 1.0f / sqrtf(s2 * (1.0f / HDA) + EPS);
#pragma unroll
        for (int j = 0; j < 8; ++j) kf[j] = kf[j] * rstd * gk[8 * ch + j];
        *(LAS v4u*)(Ks + (WIN + t) * LDA + 8 * ch) = pack8(kf); *(LAS v4u*)(Vs + (WIN + t) * LDA + 8 * ch) = vw;
        const size_t oo = ((size_t)(db * WIN + WIN - DSEQ + t) * 2 + kvh) * HDA + 8 * ch; float vf[8]; unpack8(vw, vf);
        *(GAS f32x4*)(F.out + O_WKS + oo) = (f32x4){kf[0], kf[1], kf[2], kf[3]}; *(GAS f32x4*)(F.out + O_WKS + oo + 4) = (f32x4){kf[4], kf[5], kf[6], kf[7]};
        *(GAS f32x4*)(F.out + O_WVS + oo) = (f32x4){vf[0], vf[1], vf[2], vf[3]}; *(GAS f32x4*)(F.out + O_WVS + oo + 4) = (f32x4){vf[4], vf[5], vf[6], vf[7]};
    } else if (tid < 32 + 252) { const int c = tid - 32; const v4u zz = (v4u){0u, 0u, 0u, 0u};
        *(LAS v4u*)((LAS unsigned char*)(Ks + (WIN + DSEQ) * LDA) + 16 * c) = zz; *(LAS v4u*)((LAS unsigned char*)(Vs + (WIN + DSEQ) * LDA) + 16 * c) = zz; }
    __syncthreads();
    if (F.wave == 0) { const int r = lane & 15, g = r >> 2, t = r & 3, head = kvh * 4 + g, h = lane >> 5;
        bf16* qp = QA + (size_t)(MP + db * DSEQ + t) * QAW + head * HDA;
        bf16x8 qf[4]; q_prep(qp, gq, lane, qf);
        const float slope2 = exp2f(-(float)(head + 1)) * LOG2E, sink2 = F.in[16][head] * LOG2E;
        f32x16 ot[2]; float inv;
        attn_chunk(Ks, Vs, 0, qf, t, 0, slope2, sink2, lane, ot, inv);
        if ((lane & 31) < 16) attn_store(qp, ot, inv, h);
    }
    __syncthreads();
}
DI void mlstm_scalars(LAS float* sc, const float* LFp, const float* IGp, size_t row0, int hh, int tid) {
    LAS float* sF = sc; LAS float* sB = sc + 256; LAS float* sG = sc + 512; LAS float* red = sc + 1024;
    const int lane = tid & 63, wv = tid >> 6;
    float lf = 0.f, ig = 0.f; if (tid < 256) { lf = LFp[(row0 + tid) * 4 + hh]; ig = IGp[(row0 + tid) * 4 + hh]; }
    float Fv = lf;
#pragma unroll
    for (int o = 1; o < 64; o <<= 1) { const float t = __shfl_up(Fv, o); if (lane >= o) Fv += t; }
    if (tid < 256 && lane == 63) red[wv] = Fv;
    __syncthreads();
    if (wv < 4) for (int j = 0; j < wv; ++j) Fv += red[j];
    const float bv = ig - Fv; float Gv = bv;
#pragma unroll
    for (int o = 1; o < 64; o <<= 1) { const float t = __shfl_up(Gv, o); if (lane >= o) Gv = fmaxf(Gv, t); }
    if (tid < 256 && lane == 63) red[4 + wv] = Gv;
    __syncthreads();
    if (wv < 4) for (int j = 0; j < wv; ++j) Gv = fmaxf(Gv, red[4 + j]);
    if (tid < 256) { sF[tid] = Fv; sB[tid] = bv; sG[tid] = Gv; }
    __syncthreads();
}
DI void mlstm_p1_unit(Frame& F, int ui) {
    const int b = ui >> 5, hh = (ui >> 3) & 3, c = ui & 7, tid = F.tid, lane = F.lane, w = F.wave;
    const size_t row0 = (size_t)b * SEQ + 256 * c;
    unsigned char* z = F.ws + WS_Z; const bf16* KM = (const bf16*)(z + Z_KM); const bf16* VM = (const bf16*)(z + Z_VM);
    LAS float* sc = (LAS float*)(F.lds + SC_OFF); LAS float* sW = sc + 768;
    LAS bf16* Kc = (LAS bf16*)(F.lds + T0_OFF); LAS bf16* Vw = Kc + 128 * LDM;
    mlstm_scalars(sc, (const float*)(F.ws + WS_LF), (const float*)(F.ws + WS_IG), row0, hh, tid);
    const float g255 = sc[512 + 255], FL = sc[255];
    if (tid < 256) sW[tid] = expf(sc[256 + tid] - g255);
    float* DS = (float*)(F.ws + WS_BUFA + MS_DS); if (tid == 0) { DS[ui * 2] = FL + g255; DS[ui * 2 + 1] = FL; }
    __syncthreads();
    f32x16 acc[2];
#pragma unroll
    for (int j = 0; j < 2; ++j)
#pragma unroll
        for (int i = 0; i < 16; ++i) acc[j][i] = 0.f;
    float dn = 0.f;
    const int dblk = w >> 1, eb0 = 2 * (w & 1);
#pragma unroll 1
    for (int half = 0; half < 2; ++half) {
#pragma unroll
        for (int i = 0; i < 4; ++i) { const int idx = tid + 512 * i, row = idx >> 4, ch = idx & 15, s = 128 * half + row; const size_t go = (row0 + s) * DMW + hh * HDM + 8 * ch;
            const v4u kw = *(const GAS v4u*)(KM + go), vw = *(const GAS v4u*)(VM + go); float vf[8]; unpack8(vw, vf); const float ws_ = sW[s];
#pragma unroll
            for (int j = 0; j < 8; ++j) vf[j] *= ws_;
            *(LAS v4u*)(Kc + row * LDM + 8 * ch) = kw; *(LAS v4u*)(Vw + row * LDM + 8 * ch) = pack8(vf); }
        __syncthreads();
#pragma unroll
        for (int ks = 0; ks < 8; ++ks) { const bf16x8 a = frag_t(Kc, LDM, 16 * ks, 32 * dblk, lane);
#pragma unroll
            for (int j = 0; j < 2; ++j) { const bf16x8 bb = frag_t(Vw, LDM, 16 * ks, 32 * (eb0 + j), lane); acc[j] = mfma32(a, bb, acc[j]); } }
        if (tid < 128) for (int s = 0; s < 128; ++s) dn += sW[128 * half + s] * lo16((unsigned)Kc[s * LDM + tid]);
        __syncthreads();
    }
    float* DC = (float*)(F.ws + WS_BUFA + MS_DC) + (size_t)ui * 16384; float* DN = (float*)(F.ws + WS_BUFA + MS_DN) + (size_t)ui * 128;
    const int r = lane & 31, h = lane >> 5;
#pragma unroll
    for (int j = 0; j < 2; ++j)
#pragma unroll
        for (int i = 0; i < 16; ++i) DC[(32 * dblk + crow(i, h)) * 128 + 32 * (eb0 + j) + r] = acc[j][i];
    if (tid < 128) DN[tid] = dn;
    __syncthreads();
}
DI void mlstm_p2_unit(Frame& F, int ui) {
    int tid = F.tid; asm volatile("" : "+v"(tid));
    const int b = ui >> 5, hh = (ui >> 3) & 3, c = ui & 7, lane = tid & 63, w = F.wave;
    const size_t row0 = (size_t)b * SEQ + 256 * c;
    unsigned char* z = F.ws + WS_Z; bf16* QM = (bf16*)(z + Z_QM); const bf16* KM = (const bf16*)(z + Z_KM); const bf16* VM = (const bf16*)(z + Z_VM); const bf16* OM = (const bf16*)(z + Z_OM);
    LAS float* sc = (LAS float*)(F.lds + SC_OFF);
    LAS bf16* Kc = (LAS bf16*)(F.lds + T0_OFF); LAS bf16* Vc = Kc + 128 * LDM; LAS bf16* Cs = Vc + 128 * LDM; LAS float* ns = (LAS float*)(Cs + 128 * LDM);
    mlstm_scalars(sc, (const float*)(F.ws + WS_LF), (const float*)(F.ws + WS_IG), row0, hh, tid);
    const float* DS = (const float*)(F.ws + WS_BUFA + MS_DS); const float* DCb = (const float*)(F.ws + WS_BUFA + MS_DC); const float* DNb = (const float*)(F.ws + WS_BUFA + MS_DN);
    const int u0 = ui - c;
    f32x4 C[8]; float nv = 0.f; float mc = 0.f;
#pragma unroll
    for (int i = 0; i < 8; ++i) C[i] = (f32x4){0.f, 0.f, 0.f, 0.f};
#pragma unroll 1
    for (int cp = 0; cp < c; ++cp) { const float Mc = DS[(u0 + cp) * 2], FLc = DS[(u0 + cp) * 2 + 1]; const float mn = fmaxf(FLc + mc, Mc), dec = expf(FLc + mc - mn), inj = expf(Mc - mn);
        const GAS f32x4* src = (const GAS f32x4*)(DCb + (size_t)(u0 + cp) * 16384);
#pragma unroll
        for (int i = 0; i < 8; ++i) C[i] = C[i] * dec + src[tid + 512 * i] * inj;
        if (tid < 128) nv = nv * dec + DNb[(size_t)(u0 + cp) * 128 + tid] * inj;
        mc = mn; }
#pragma unroll
    for (int i = 0; i < 8; ++i) { const int idx = 4 * (tid + 512 * i), d = idx >> 7, e = idx & 127; *(LAS u32x2*)(Cs + d * LDM + e) = (u32x2){pk2(C[i].x, C[i].y), pk2(C[i].z, C[i].w)}; }
    if (tid < 128) ns[tid] = nv;
    if (c == 7) {
        const float Mc = DS[ui * 2], FLc = DS[ui * 2 + 1]; const float mn = fmaxf(FLc + mc, Mc), dec = expf(FLc + mc - mn), inj = expf(Mc - mn);
        const GAS f32x4* src = (const GAS f32x4*)(DCb + (size_t)ui * 16384); GAS f32x4* dst = (GAS f32x4*)(F.out + O_CP + (size_t)(b * 4 + hh) * 16384);
#pragma unroll
        for (int i = 0; i < 8; ++i) dst[tid + 512 * i] = C[i] * dec + src[tid + 512 * i] * inj;
        if (tid < 128) F.out[O_NP + (size_t)(b * 4 + hh) * 128 + tid] = nv * dec + DNb[(size_t)ui * 128 + tid] * inj;
        if (tid == 0) F.out[O_MP + b * 4 + hh] = mn;
    }
    const int r = lane & 31, h = lane >> 5, t = 32 * w + r;
    bf16* qp = QM + (row0 + t) * DMW + hh * HDM;
    bf16x8 qf[8];
#pragma unroll
    for (int ks = 0; ks < 8; ++ks) qf[ks] = __builtin_bit_cast(bf16x8, *(const GAS v4u*)(qp + 16 * ks + 8 * h));
    __syncthreads();
    const float mu = fmaxf(mc, sc[512 + t]), at = expf(mc - mu);
    f32x16 nt[4];
#pragma unroll
    for (int eb = 0; eb < 4; ++eb) {
#pragma unroll
        for (int i = 0; i < 16; ++i) nt[eb][i] = 0.f;
#pragma unroll
        for (int ks = 0; ks < 8; ++ks) { const bf16x8 a = frag_t(Cs, LDM, 16 * ks, 32 * eb, lane); nt[eb] = mfma32(a, qf[ks], nt[eb]); }
#pragma unroll
        for (int i = 0; i < 16; ++i) nt[eb][i] *= at;
    }
    float qn = 0.f;
#pragma unroll
    for (int ks = 0; ks < 8; ++ks) { float f[8]; unpack8(__builtin_bit_cast(v4u, qf[ks]), f);
#pragma unroll
        for (int j = 0; j < 8; ++j) qn += f[j] * ns[16 * ks + 8 * h + j]; }
    qn += __shfl_xor(qn, 32);
    float rowsum = 0.f;
#pragma unroll 1
    for (int half = 0; half < 2; ++half) {
#pragma unroll
        for (int i = 0; i < 4; ++i) { const int idx = tid + 512 * i, row = idx >> 4, ch = idx & 15, s = 128 * half + row; const size_t go = (row0 + s) * DMW + hh * HDM + 8 * ch;
            *(LAS v4u*)(Kc + row * LDM + 8 * ch) = *(const GAS v4u*)(KM + go); *(LAS v4u*)(Vc + row * LDM + 8 * ch) = *(const GAS v4u*)(VM + go); }
        __syncthreads();
        if (w >= 4 * half) { const int nblk = (w - 4 * half + 1) < 4 ? (w - 4 * half + 1) : 4;
#pragma unroll 1
            for (int jb = 0; jb < nblk; ++jb) { const int sb = 4 * half + jb;
                f32x16 st;
#pragma unroll
                for (int i = 0; i < 16; ++i) st[i] = 0.f;
#pragma unroll
                for (int ks = 0; ks < 8; ++ks) { const bf16x8 a = *(const LAS bf16x8*)(Kc + (32 * jb + r) * LDM + 16 * ks + 8 * h); st = mfma32(a, qf[ks], st); }
#pragma unroll
                for (int i = 0; i < 16; ++i) { const int s = 32 * sb + crow(i, h); const float dcy = (s <= t) ? __builtin_amdgcn_exp2f((sc[256 + s] - mu) * LOG2E) : 0.f; const float wv = st[i] * dcy; st[i] = wv; rowsum += wv; }
#pragma unroll
                for (int s2 = 0; s2 < 2; ++s2) { const bf16x8 pf = packacc(st, s2);
#pragma unroll
                    for (int eb = 0; eb < 4; ++eb) { const bf16x8 vf = frag_tp(Vc, LDM, 32 * jb + 16 * s2, 32 * eb, lane); nt[eb] = mfma32(vf, pf, nt[eb]); } }
            } }
        __syncthreads();
    }
    rowsum += __shfl_xor(rowsum, 32);
    const float den = at * qn + rowsum, mt = sc[t] + mu, dnm = fmaxf(fabsf(den), expf(-mt)), invd = 1.0f / dnm;
    float s2 = 0.f;
#pragma unroll
    for (int eb = 0; eb < 4; ++eb)
#pragma unroll
        for (int i = 0; i < 16; ++i) { nt[eb][i] *= invd; s2 += nt[eb][i] * nt[eb][i]; }
    s2 += __shfl_xor(s2, 32);
    const float rstd = 1.0f / sqrtf(s2 * (1.0f / HDM) + EPS);
    const float* ghm = F.in[17] + hh * HDM; const bf16* op = OM + (row0 + t) * DMW + hh * HDM;
#pragma unroll
    for (int eb = 0; eb < 4; ++eb)
#pragma unroll
        for (int i4 = 0; i4 < 4; ++i4) { const int e = 32 * eb + 8 * i4 + 4 * h; const f32x4 g = *(const GAS f32x4*)(ghm + e); const u32x2 ow = *(const GAS u32x2*)(op + e);
            u32x2 o; o.x = pk2(nt[eb][4 * i4] * rstd * g.x * lo16(ow.x), nt[eb][4 * i4 + 1] * rstd * g.y * hi16(ow.x)); o.y = pk2(nt[eb][4 * i4 + 2] * rstd * g.z * lo16(ow.y), nt[eb][4 * i4 + 3] * rstd * g.w * hi16(ow.y));
            *(GAS u32x2*)(qp + e) = o; asm volatile("" ::: "memory"); }
    __syncthreads();
}
DI void mlstm_sample_unit(Frame& F, int ui) {
    const int db = ui >> 2, hh = ui & 3, tid = F.tid, lane = F.lane;
    const size_t row0 = (size_t)MP + db * DSEQ;
    unsigned char* z = F.ws + WS_Z; bf16* QM = (bf16*)(z + Z_QM); const bf16* KM = (const bf16*)(z + Z_KM); const bf16* VM = (const bf16*)(z + Z_VM); const bf16* OM = (const bf16*)(z + Z_OM);
    LAS float* sq = (LAS float*)(F.lds + T0_OFF); LAS float* sk = sq + 512; LAS float* sv = sk + 512; LAS float* sqk = sv + 512; LAS float* sqn = sqk + 16; LAS float* sred = sqn + 16; LAS float* red = sred + 16;
    const float* LFp = (const float*)(F.ws + WS_LF); const float* IGp = (const float*)(F.ws + WS_IG);
    { const int t = tid >> 7, dd = tid & 127; const size_t go = (row0 + t) * DMW + hh * HDM + dd; sq[tid] = lo16((unsigned)QM[go]); sk[tid] = lo16((unsigned)KM[go]); sv[tid] = lo16((unsigned)VM[go]); }
    float Fc[4], ig[4]; { float a = 0.f;
#pragma unroll
        for (int t = 0; t < 4; ++t) { a += LFp[(row0 + t) * 4 + hh]; Fc[t] = a; ig[t] = IGp[(row0 + t) * 4 + hh]; } }
    const float m0 = F.in[6][db * 4 + hh]; const float* n0p = F.in[5] + (size_t)(db * 4 + hh) * 128;
    __syncthreads();
    if (tid < 16) { const int t = tid >> 2, s = tid & 3; float a = 0.f; for (int d = 0; d < 128; ++d) a += sq[t * 128 + d] * sk[s * 128 + d]; sqk[tid] = a; }
    else if (tid < 20) { const int t = tid - 16; float a = 0.f; for (int d = 0; d < 128; ++d) a += sq[t * 128 + d] * n0p[d]; sqn[t] = a; }
    float mt[4], ai[4];
#pragma unroll
    for (int t = 0; t < 4; ++t) { float mx = Fc[t] + m0;
#pragma unroll
        for (int s = 0; s < 4; ++s) if (s <= t) mx = fmaxf(mx, Fc[t] - Fc[s] + ig[s]);
        mt[t] = mx; ai[t] = expf(Fc[t] + m0 - mx); }
    const float mnew = mt[3], dec = expf(Fc[3] + m0 - mnew);
    float wsv[4];
#pragma unroll
    for (int s = 0; s < 4; ++s) wsv[s] = expf(Fc[3] - Fc[s] + ig[s] - mnew);
    __syncthreads();
    const int e = tid & 127, qtr = tid >> 7;
    const float* C0 = F.in[4] + (size_t)(db * 4 + hh) * 16384; float* C1 = F.out + O_CS + (size_t)(db * 4 + hh) * 16384;
    float ve[4];
#pragma unroll
    for (int s = 0; s < 4; ++s) ve[s] = sv[s * 128 + e];
    float part[4] = {0.f, 0.f, 0.f, 0.f};
#pragma unroll 4
    for (int dd = 0; dd < 32; ++dd) { const int d = 32 * qtr + dd; const float c0 = C0[d * 128 + e]; float c1 = dec * c0;
#pragma unroll
        for (int s = 0; s < 4; ++s) { part[s] += sq[s * 128 + d] * c0; c1 += wsv[s] * sk[s * 128 + d] * ve[s]; }
        C1[d * 128 + e] = c1; }
#pragma unroll
    for (int t = 0; t < 4; ++t) red[(qtr * 4 + t) * 128 + e] = part[t];
    __syncthreads();
    if (tid < 128) {
        float hv[4]; float s2p[4];
#pragma unroll
        for (int t = 0; t < 4; ++t) { const float inter = (red[(0 * 4 + t) * 128 + e] + red[(1 * 4 + t) * 128 + e]) + (red[(2 * 4 + t) * 128 + e] + red[(3 * 4 + t) * 128 + e]);
            float num = ai[t] * inter, den = ai[t] * sqn[t];
#pragma unroll
            for (int s = 0; s < 4; ++s) if (s <= t) { const float wts = sqk[t * 4 + s] * expf(Fc[t] - Fc[s] + ig[s] - mt[t]); num += wts * ve[s]; den += wts; }
            hv[t] = num / fmaxf(fabsf(den), expf(-mt[t])); s2p[t] = wave_sum(hv[t] * hv[t]); }
        if (lane == 0) {
#pragma unroll
            for (int t = 0; t < 4; ++t) sred[(tid >> 6) * 4 + t] = s2p[t]; }
        float n1 = dec * n0p[tid];
#pragma unroll
        for (int s = 0; s < 4; ++s) n1 += wsv[s] * sk[s * 128 + tid];
        F.out[O_NS + (size_t)(db * 4 + hh) * 128 + tid] = n1;
        if (tid == 0) F.out[O_MS + db * 4 + hh] = mnew;
        asm volatile("s_waitcnt lgkmcnt(0)" ::: "memory");
#pragma unroll
        for (int t = 0; t < 4; ++t) red[t * 128 + e] = hv[t];
    }
    __syncthreads();
    if (tid < 128) {
        const float g = F.in[17][hh * HDM + e];
#pragma unroll
        for (int t = 0; t < 4; ++t) { const float s2 = sred[t] + sred[4 + t]; const float rstd = 1.0f / sqrtf(s2 * (1.0f / HDM) + EPS); const size_t go = (row0 + t) * DMW + hh * HDM + e;
            const float o = red[t * 128 + e] * rstd * g * lo16((unsigned)OM[go]); QM[go] = (bf16)(pk2(o, 0.f) & 0xffffu); }
    }
    __syncthreads();
}
DI void conv_fixup(Frame& F) {
    unsigned char* z = F.ws + WS_Z; const float* UB = (const float*)(z + Z_UB); bf16* ACT = (bf16*)(z + Z_ACT);
    const float* cw = F.in[23]; const float* cb = F.in[24];
    const int gt = F.bid * (NWAVES * 64) + F.tid, NT = F.G * NWAVES * 64;
    for (int it = gt; it < (MP / 64) * (DFF / 4); it += NT) { const int sb = it / (DFF / 4), ja = 4 * (it % (DFF / 4)); const bool first = (sb % (SEQ / 64)) == 0;
        const f32x4 zero = (f32x4){0.f, 0.f, 0.f, 0.f};
        f32x4 y0[2], y1[2];
#pragma unroll
        for (int hb = 0; hb < 2; ++hb) { const int col = hb * DFF + ja;
            const f32x4 um2 = first ? zero : *(const GAS f32x4*)(UB + ((size_t)(sb - 1) * 4 + 2) * F2 + col), um1 = first ? zero : *(const GAS f32x4*)(UB + ((size_t)(sb - 1) * 4 + 3) * F2 + col);
            const f32x4 u0 = *(const GAS f32x4*)(UB + ((size_t)sb * 4 + 0) * F2 + col), u1 = *(const GAS f32x4*)(UB + ((size_t)sb * 4 + 1) * F2 + col);
            const f32x4 w0 = *(const GAS f32x4*)(cw + col), w1 = *(const GAS f32x4*)(cw + F2 + col), w2 = *(const GAS f32x4*)(cw + 2 * F2 + col), bb = *(const GAS f32x4*)(cb + col);
            y0[hb] = bb + w0 * um2 + w1 * um1 + w2 * u0; y1[hb] = bb + w0 * um1 + w1 * u0 + w2 * u1; }
        const f32x4 r0 = (f32x4){ep::gelu_t(y0[0][0]) * y0[1][0], ep::gelu_t(y0[0][1]) * y0[1][1], ep::gelu_t(y0[0][2]) * y0[1][2], ep::gelu_t(y0[0][3]) * y0[1][3]};
        const f32x4 r1 = (f32x4){ep::gelu_t(y1[0][0]) * y1[1][0], ep::gelu_t(y1[0][1]) * y1[1][1], ep::gelu_t(y1[0][2]) * y1[1][2], ep::gelu_t(y1[0][3]) * y1[1][3]};
        *(GAS u32x2*)(ACT + (size_t)(64 * sb) * DFF + ja) = ep::pk4(r0); *(GAS u32x2*)(ACT + (size_t)(64 * sb + 1) * DFF + ja) = ep::pk4(r1);
    }
    for (int it = gt; it < NBATCH * 2 * (F2 / 4); it += NT) { const int b = it / (2 * (F2 / 4)), k = (it / (F2 / 4)) & 1, c4 = it % (F2 / 4);
        *(GAS f32x4*)(F.out + O_CONVP + ((size_t)(b * 2 + k)) * F2 + 4 * c4) = *(const GAS f32x4*)(UB + ((size_t)((SEQ / 64) * (b + 1) - 1) * 4 + 2 + k) * F2 + 4 * c4); }
}

#ifndef MK_N_LAUNCHES
#define MK_N_LAUNCHES 10
#endif
constexpr int PER_PHASE = 10;
constexpr int N_LAUNCHES = MK_N_LAUNCHES;
static_assert(N_LAUNCHES == 1 || N_LAUNCHES == PER_PHASE, "MK_N_LAUNCHES is 1 or 10");
#ifndef PG8_SP2
#define PG8_SP2 true
#endif
#ifndef PG8_ALIGN
#define PG8_ALIGN true
#endif
struct Args { const float* in[28]; float* out; unsigned char* ws; int ph_lo, ph_hi, li, pad; };
__global__ void __launch_bounds__(NWAVES * 64, 2) hybrid_fwd(Args args) {
    extern __shared__ __attribute__((aligned(16))) unsigned char lds[];
    Frame F;
    F.lds = (LAS unsigned char*)lds;
    F.MISC = (volatile LAS unsigned*)(F.lds + MISC_OFF);
    F.tid = threadIdx.x; F.lane = F.tid & 63; F.wave = __builtin_amdgcn_readfirstlane(F.tid >> 6);
    F.G = gridDim.x; F.bid = blockIdx.x;
#pragma unroll
    for (int i = 0; i < 28; ++i) F.in[i] = args.in[i];
    F.out = args.out; F.ws = args.ws;
    F.ctl = (gu32*)(args.ws + WS_CTL);
    for (int u = F.tid; u < (LDS_BYTES - LDSCTL_OFF) / 4; u += NWAVES * 64) ((LAS unsigned*)(F.lds + LDSCTL_OFF))[u] = 0u;
    __syncthreads();
    XcdBarrier bar; bar.bar = (unsigned*)(F.ctl + CW_BAR); bar.x = 0; bar.st = nullptr;
    if (N_LAUNCHES == 1) bar = xcd_barrier_post((unsigned*)(F.ctl + CW_BAR), F.MISC + 8);
#define GRID_BAR() do { if (N_LAUNCHES == 1) xcd_barrier(bar); } while (0)
    const int lo = args.ph_lo, hi = args.ph_hi;
#ifndef PHASE_MASK
#define PHASE_MASK 0x3ff
#endif
#define IN(k) ((((PHASE_MASK) >> (k)) & 1) && lo <= (k) && (k) < hi)
#define BOTH(k) (IN(k) && IN((k) + 1))
    unsigned char* ws = args.ws; unsigned char* z = ws + WS_Z;
    bf16* BUFA = (bf16*)(ws + WS_BUFA);

    if (IN(0)) { p0_prologue(F); if (BOTH(0)) GRID_BAR(); }

    if (IN(1)) {
        pg8::Gemm g{BUFA, (const bf16*)(ws + WS_WIN), M, N1, D}; pg8::StaticOrder S; S.init(M, N1, F.G, F.bid);
        ep::EpiZ E{z};
        pg8::gemm_phase<ep::EpiZ, pg8::StaticOrder, PG8_ALIGN, PG8_SP2>(F.lds + RING_OFF, g, S, E);
        if (BOTH(1)) GRID_BAR();
    }

    if (IN(2)) {
        if (F.tid < 64) ((LAS float*)(F.lds + GQ_OFF))[F.tid] = F.in[14][F.tid]; else if (F.tid < 128) ((LAS float*)(F.lds + GQ_OFF))[F.tid] = F.in[15][F.tid - 64];
        __syncthreads();
#ifndef UNIT_MASK
#define UNIT_MASK 15
#endif
#pragma unroll 1
        for (int i = F.bid; i < 256; i += F.G) { if (UNIT_MASK & 1) attn_prompt_unit(F, i); }
#pragma unroll 1
        for (int i = F.bid; i < 256; i += F.G) { if (UNIT_MASK & 2) mlstm_p1_unit(F, i); }
#pragma unroll 1
        for (int i = F.bid; i < 256; i += F.G) { if (UNIT_MASK & 4) attn_sample_unit(F, i); }
#pragma unroll 1
        for (int i = F.bid; i < 512; i += F.G) { if (UNIT_MASK & 8) mlstm_sample_unit(F, i); }
        if (BOTH(2)) GRID_BAR();
    }

    if (IN(3)) {
#pragma unroll 1
        for (int i = F.bid; i < 256; i += F.G) mlstm_p2_unit(F, i);
        if (BOTH(3)) GRID_BAR();
    }

    if (IN(4)) {
        { pg8::Gemm g{(const bf16*)(z + Z_QA), (const bf16*)(ws + WS_WOA), M, D, QAW}; pg8::StaticOrder S; S.init(M, D, F.G, F.bid);
          ep::EpiMix<0> E{(const bf16*)(z + Z_GA), (bf16*)(z + Z_MIXED)};
          pg8::gemm_phase<ep::EpiMix<0>, pg8::StaticOrder, PG8_ALIGN, PG8_SP2>(F.lds + RING_OFF, g, S, E); }
        { pg8::Gemm g{(const bf16*)(z + Z_QM), (const bf16*)(ws + WS_WOM), M, D, DMW}; pg8::StaticOrder S; S.init(M, D, F.G, F.bid);
          ep::EpiMix<1> E{(const bf16*)(z + Z_GM), (bf16*)(z + Z_MIXED)};
          pg8::gemm_phase<ep::EpiMix<1>, pg8::StaticOrder, PG8_ALIGN, PG8_SP2>(F.lds + RING_OFF, g, S, E); }
        if (BOTH(4)) GRID_BAR();
    }

    if (IN(5)) {
        pg8::Gemm g{(const bf16*)(z + Z_MIXED), (const bf16*)(ws + WS_WOUT), M, D, D}; pg8::StaticOrder S; S.init(M, D, F.G, F.bid);
        ep::EpiX1 E{F.in[0], F.in[1], F.out + O_Y, BUFA, (float*)(ws + WS_SS)};
        pg8::gemm_phase<ep::EpiX1, pg8::StaticOrder, PG8_ALIGN, PG8_SP2>(F.lds + RING_OFF, g, S, E);
        if (BOTH(5)) GRID_BAR();
    }

    if (IN(6)) {
        pg8::Gemm g{BUFA, (const bf16*)(ws + WS_WUP), M, F2, D}; pg8::StaticOrder S; S.init(M, F2, F.G, F.bid);
        ep::EpiConv E{(const float*)(ws + WS_SS), F.in[23], F.in[24], F.in[7], (bf16*)(z + Z_ACT), (float*)(z + Z_UB), F.out + O_CONVS};
        pg8::gemm_phase<ep::EpiConv, pg8::StaticOrder, PG8_ALIGN, PG8_SP2>(F.lds + RING_OFF, g, S, E);
        if (BOTH(6)) GRID_BAR();
    }

    if (IN(7)) {
        conv_fixup(F);
        pg8::Gemm g{(const bf16*)(ws + WS_PB), (const bf16*)(ws + WS_WPLE), M, D, PLE}; pg8::StaticOrder S; S.init(M, D, F.G, F.bid);
        ep::EpiT E{(bf16*)(z + Z_TPLE)};
        pg8::gemm_phase<ep::EpiT, pg8::StaticOrder, PG8_ALIGN, PG8_SP2>(F.lds + RING_OFF, g, S, E);
        if (BOTH(7)) GRID_BAR();
    }

    if (IN(8)) {
        pg8::Gemm g{(const bf16*)(z + Z_ACT), (const bf16*)(ws + WS_WDN), M, D, DFF}; pg8::StaticOrder S; S.init(M, D, F.G, F.bid);
        ep::EpiX2 E{F.out + O_Y, BUFA};
        pg8::gemm_phase<ep::EpiX2, pg8::StaticOrder, PG8_ALIGN, PG8_SP2>(F.lds + RING_OFF, g, S, E);
        if (BOTH(8)) GRID_BAR();
    }

    if (IN(9)) {
        pg8::Gemm g{BUFA, (const bf16*)(ws + WS_WG), M, D, D}; pg8::StaticOrder S; S.init(M, D, F.G, F.bid);
        ep::EpiY E{F.out + O_Y, (const bf16*)(z + Z_TPLE)};
        pg8::gemm_phase<ep::EpiY, pg8::StaticOrder, PG8_ALIGN, PG8_SP2>(F.lds + RING_OFF, g, S, E);
    }
#undef IN
#undef BOTH
#undef GRID_BAR
}

extern "C" void kernel_launch(void* const* d_in, const int* in_sizes, int n_in, void* d_out, int out_size, void* d_ws, size_t ws_size, hipStream_t stream) {
    static int grid = 0;
    if (grid == 0) {
        if (n_in != 28 || in_sizes[0] != MP * D || (size_t)out_size != O_END || ws_size < WS_END) {
            fprintf(stderr, "kernel_launch: built for 28 inputs, x_prompt of %d floats, out of %zu floats, >= %zu bytes of workspace; got n_in %d, in0 %d, out %d, ws %zu; nothing launched\n", MP * D, (size_t)O_END, (size_t)WS_END, n_in, n_in > 0 ? in_sizes[0] : -1, out_size, ws_size); grid = -1; return; }
        int dev = 0, cus = 0, per_cu = 0;
        if (hipGetDevice(&dev) != hipSuccess || hipDeviceGetAttribute(&cus, hipDeviceAttributeMultiprocessorCount, dev) != hipSuccess) { fprintf(stderr, "kernel_launch: device query failed\n"); grid = -1; return; }
        if (hipFuncSetAttribute((const void*)hybrid_fwd, hipFuncAttributeMaxDynamicSharedMemorySize, LDS_BYTES) != hipSuccess) { fprintf(stderr, "kernel_launch: hipFuncSetAttribute failed\n"); grid = -1; return; }
        if (hipOccupancyMaxActiveBlocksPerMultiprocessor(&per_cu, (const void*)hybrid_fwd, NWAVES * 64, LDS_BYTES) != hipSuccess || per_cu < 1) { fprintf(stderr, "kernel_launch: occupancy query reports %d workgroups per CU; nothing launched\n", per_cu); (void)hipGetLastError(); grid = -1; return; }
        (void)hipGetLastError();
        grid = cus;
    }
    if (grid < 0) return;
    if (hipMemsetAsync((char*)d_ws + WS_CTL, 0, CTL_ZERO_BYTES, stream) != hipSuccess) { fprintf(stderr, "kernel_launch: hipMemsetAsync failed\n"); return; }
    Args a{};
    for (int i = 0; i < 28; ++i) a.in[i] = (const float*)d_in[i];
    a.out = (float*)d_out; a.ws = (unsigned char*)d_ws;
    for (int li = 0; li < N_LAUNCHES; ++li) {
        a.ph_lo = (N_LAUNCHES == PER_PHASE) ? li : 0; a.ph_hi = (N_LAUNCHES == PER_PHASE) ? li + 1 : PER_PHASE; a.li = li;
        hipLaunchKernelGGL(hybrid_fwd, dim3(grid), dim3(NWAVES * 64), LDS_BYTES, stream, a);
        const hipError_t le = hipPeekAtLastError();
        if (le != hipSuccess) { fprintf(stderr, "kernel_launch: launch %d failed: %s\n", li, hipGetErrorName(le)); break; }
    }
}
```

```cpp
#include <hip/hip_runtime.h>
#include <cstdio>
#include <cstdint>
#include <cmath>
namespace pg8 {
#define PG8_LAS __attribute__((address_space(3)))
typedef unsigned short bf16_t;
typedef short bf16x8 __attribute__((ext_vector_type(8)));
typedef float f32x4 __attribute__((ext_vector_type(4)));
typedef unsigned u32x4 __attribute__((ext_vector_type(4)));
constexpr int BM = 256, BK = 64, HALF = 128, HTB = HALF * BK * 2  , STAGE_BYTES = 8 * HTB, NXCD = 8, WGM = 8;

__host__ __device__ __forceinline__ int lds_byte(int r, int c) { const int st = (r >> 4) * 2 + (c >> 5), rr = r & 15, cc = c & 31, ob = rr * 64 + cc * 2; return st * 1024 + (ob ^ (((ob >> 9) & 1) << 5)); }
__host__ __device__ __forceinline__ void stage_rc(int b, int& R, int& C) { const int st = b / 1024, sb = b % 1024, swz = sb ^ (((sb >> 9) & 1) << 5); R = (st >> 1) * 16 + swz / 64; C = (st & 1) * 32 + (swz % 64) / 2; }
__host__ __device__ __forceinline__ int perm32(int rho) { const int n = rho >> 4, i = rho & 15; return 8 * (i >> 2) + 4 * n + (i & 3); }

struct Unit { int pm, pn; };
struct Gemm { const bf16_t* A; const bf16_t* Bt; int M, N, K; };

struct StaticOrder {
    int nM, nN, nwg, G, c;
    __host__ __device__ void init(int M, int N, int G_, int c_) { nM = M / BM; nN = N / BM; nwg = nM * nN; G = G_; c = c_; }
    __host__ __device__ bool next(int i, Unit& u) const {
        const long L = (long)i * G + c; if (L >= nwg) return false;
        int wgid = (int)L; { const int q = nwg / NXCD, r = nwg % NXCD, xcd = wgid % NXCD, off = wgid / NXCD; wgid = (xcd < r ? xcd * (q + 1) : r * (q + 1) + (xcd - r) * q) + off; }
        const int nig = WGM * nN, gid = wgid / nig, fm = gid * WGM, gsz = (nM - fm) < WGM ? (nM - fm) : WGM;
        u.pm = fm + ((wgid % nig) % gsz); u.pn = (wgid % nig) / gsz; return true;
    }
    __device__ __forceinline__ void a_ready(const Unit&) const {}
    __device__ __forceinline__ void done(const Unit&) const {}
};

template <class Epi, class Sched, bool ALIGN_EPI = false, bool SP2 = false>
__device__ __forceinline__ void gemm_phase(PG8_LAS unsigned char* lds, const Gemm g, const Sched& S, const Epi& E, const int wid) {
    unsigned z0_ = 0u; asm volatile("" : "+v"(z0_)); int lane_ = __builtin_amdgcn_mbcnt_hi(~0u, __builtin_amdgcn_mbcnt_lo(~0u, z0_)); asm volatile("" : "+v"(lane_));
    const int lane = lane_, tid = wid * 64 + lane, wr = wid >> 2, wc = wid & 3, fr = lane & 15, fq = lane >> 4;
    const int K = g.K, nt = K / BK;
    unsigned voffA[2], voffB[2];
#pragma unroll
    for (int i = 0; i < 2; ++i) { int R, C; stage_rc(tid * 16 + i * 8192, R, C); const int Rb = Epi::PERM ? ((R & ~31) + perm32(R & 31)) : R;
        const int Ra = Epi::PERMA ? ((R & 64) + 4 * (R & 15) + ((R >> 4) & 3)) : R;
        voffA[i] = (unsigned)(Ra * K + C) * 2u; voffB[i] = (unsigned)(Rb * K + C) * 2u; }
    const size_t kstep = (size_t)(BK * 2);
    const size_t hstep = (size_t)HALF * K * 2;
    const size_t tstep = 2 * hstep;
    const unsigned ldsw = (unsigned)wid * 1024u;
    const int aoff = lds_byte(wr * 64 + fr, fq * 8), boff = lds_byte(wc * 32 + fr, fq * 8);
#define PG8_SA(b, h) (((b) * 2 + (h)) * HTB)
#define PG8_SB(b, h) ((4 + (b) * 2 + (h)) * HTB)
#define PG8_STAGE(bufoff, gbase, voff) do { _Pragma("unroll") for (int _i = 0; _i < 2; ++_i) \
        __builtin_amdgcn_global_load_lds((const unsigned*)((const char*)(gbase) + (voff)[_i]), (PG8_LAS unsigned*)(lds + (bufoff) + ldsw + _i * 8192), 16, 0, 0); } while (0)
#define PG8_LDA(dst, b, h) do { _Pragma("unroll") for (int m = 0; m < 4; ++m) _Pragma("unroll") for (int k = 0; k < 2; ++k) dst[m][k] = *(const PG8_LAS bf16x8*)(lds + PG8_SA(b, h) + aoff + m * 2048 + k * 1024); } while (0)
#define PG8_LDB(dst, b, h) do { _Pragma("unroll") for (int n = 0; n < 2; ++n) _Pragma("unroll") for (int k = 0; k < 2; ++k) dst[n][k] = *(const PG8_LAS bf16x8*)(lds + PG8_SB(b, h) + boff + n * 2048 + k * 1024); } while (0)
#define PG8_MMA(ai, bj, At, Bt) do { __builtin_amdgcn_s_setprio(1); _Pragma("unroll") for (int m = 0; m < 4; ++m) _Pragma("unroll") for (int n = 0; n < 2; ++n) _Pragma("unroll") for (int k = 0; k < 2; ++k) \
        acc[ai][bj][m][n] = __builtin_amdgcn_mfma_f32_16x16x32_bf16(Bt[n][k], At[m][k], acc[ai][bj][m][n], 0, 0, 0); __builtin_amdgcn_s_setprio(0); } while (0)
#define PG8_WAIT_V(n) asm volatile("s_waitcnt vmcnt(" #n ")" ::: "memory")
#define PG8_WAIT_L(n) asm volatile("s_waitcnt lgkmcnt(" #n ")" ::: "memory")
#define PG8_BAR __builtin_amdgcn_s_barrier()
#define PG8_SCHED __builtin_amdgcn_sched_barrier(0)
    Unit cur, nxt; int ui = 0;
    if (!S.next(0, cur)) return;
    f32x4 acc[2][2][4][2];
#pragma unroll
    for (int a = 0; a < 2; ++a)
#pragma unroll
        for (int b = 0; b < 2; ++b)
#pragma unroll
            for (int m = 0; m < 4; ++m)
#pragma unroll
                for (int n = 0; n < 2; ++n) acc[a][b][m][n] = (f32x4){0.f, 0.f, 0.f, 0.f};
    bf16x8 At[4][2], B0[2][2], B1[2][2];
    const char* cA = (const char*)g.A + (size_t)cur.pm * tstep; const char* cB = (const char*)g.Bt + (size_t)cur.pn * tstep;
    S.a_ready(cur);
    if constexpr (SP2) {
        PG8_STAGE(PG8_SB(0, 0), cB, voffB); PG8_STAGE(PG8_SB(0, 1), cB + hstep, voffB); PG8_STAGE(PG8_SA(0, 0), cA, voffA); PG8_STAGE(PG8_SA(0, 1), cA + hstep, voffA);
        if (wr == 1) PG8_BAR;
        PG8_WAIT_V(2); PG8_BAR;
        PG8_STAGE(PG8_SB(1, 0), cB + kstep, voffB); PG8_STAGE(PG8_SA(1, 0), cA + kstep, voffA); PG8_STAGE(PG8_SB(1, 1), cB + hstep + kstep, voffB);
        PG8_WAIT_V(6); PG8_BAR;
    } else {
        PG8_STAGE(PG8_SB(0, 0), cB, voffB); PG8_STAGE(PG8_SA(0, 0), cA, voffA); PG8_STAGE(PG8_SB(0, 1), cB + hstep, voffB); PG8_STAGE(PG8_SA(0, 1), cA + hstep, voffA);
        if (wr == 1) PG8_BAR;
        PG8_WAIT_V(4); PG8_BAR;
        PG8_STAGE(PG8_SB(1, 0), cB + kstep, voffB); PG8_STAGE(PG8_SA(1, 0), cA + kstep, voffA); PG8_STAGE(PG8_SB(1, 1), cB + hstep + kstep, voffB);
        PG8_WAIT_V(6); PG8_BAR;
    }
    for (;;) {
        const bool has_next = S.next(ui + 1, nxt);
        const char* nA = has_next ? (const char*)g.A + (size_t)nxt.pm * tstep : cA; const char* nB = has_next ? (const char*)g.Bt + (size_t)nxt.pn * tstep : cB;
        for (int t = 0; t < nt; t += 2) {
            if constexpr (Epi::MIDT > 0) { if (t == Epi::MIDT) E.mid(acc, cur, wr, wc, fr, fq); }
            const bool last = (t == nt - 2);
            const char* a1 = cA + (size_t)(t + 1) * kstep;
            const char* a2 = last ? nA : cA + (size_t)(t + 2) * kstep; const char* b2 = last ? nB : cB + (size_t)(t + 2) * kstep;
            const char* a3 = a2 + kstep; const char* b3 = b2 + kstep;
            if (last && has_next) S.a_ready(nxt);
            if constexpr (SP2) {
            PG8_LDB(B0, 0, 0); PG8_LDB(B1, 0, 1); PG8_SCHED; PG8_LDA(At, 0, 0); PG8_STAGE(PG8_SA(1, 1), a1 + hstep, voffA);
            PG8_WAIT_V(8); PG8_WAIT_L(0); PG8_BAR; PG8_MMA(0, 0, At, B0); PG8_MMA(0, 1, At, B1); PG8_BAR; PG8_SCHED;
            PG8_LDA(At, 0, 1); PG8_STAGE(PG8_SB(0, 0), b2, voffB); PG8_STAGE(PG8_SB(0, 1), b2 + hstep, voffB); PG8_STAGE(PG8_SA(0, 0), a2, voffA);
            PG8_WAIT_V(8); PG8_WAIT_L(0); PG8_BAR; PG8_MMA(1, 0, At, B0); PG8_MMA(1, 1, At, B1); PG8_BAR; PG8_SCHED;
            PG8_LDB(B0, 1, 0); PG8_LDB(B1, 1, 1); PG8_SCHED; PG8_LDA(At, 1, 0); PG8_STAGE(PG8_SA(0, 1), a2 + hstep, voffA);
            PG8_WAIT_V(8); PG8_WAIT_L(0); PG8_BAR; PG8_MMA(0, 0, At, B0); PG8_MMA(0, 1, At, B1); PG8_BAR; PG8_SCHED;
            PG8_LDA(At, 1, 1); PG8_STAGE(PG8_SB(1, 0), b3, voffB); PG8_STAGE(PG8_SB(1, 1), b3 + hstep, voffB); PG8_STAGE(PG8_SA(1, 0), a3, voffA);
            PG8_WAIT_V(8); PG8_WAIT_L(0); PG8_BAR; PG8_MMA(1, 0, At, B0); PG8_MMA(1, 1, At, B1); PG8_BAR; PG8_SCHED;
            } else {
            PG8_LDB(B0, 0, 0); PG8_SCHED; PG8_LDA(At, 0, 0); PG8_STAGE(PG8_SA(1, 1), a1 + hstep, voffA);
            PG8_WAIT_L(8); PG8_BAR; PG8_WAIT_L(0); PG8_MMA(0, 0, At, B0); PG8_BAR; PG8_SCHED;
            PG8_LDB(B1, 0, 1); PG8_STAGE(PG8_SB(0, 0), b2, voffB);
            PG8_BAR; PG8_WAIT_L(0); PG8_MMA(0, 1, At, B1); PG8_BAR;
            PG8_LDA(At, 0, 1); PG8_STAGE(PG8_SA(0, 0), a2, voffA);
            PG8_BAR; PG8_WAIT_L(0); PG8_MMA(1, 0, At, B0); PG8_BAR; PG8_SCHED;
            PG8_STAGE(PG8_SB(0, 1), b2 + hstep, voffB);
            PG8_WAIT_V(6); PG8_BAR; PG8_MMA(1, 1, At, B1); PG8_BAR;
            PG8_LDB(B0, 1, 0); PG8_SCHED; PG8_LDA(At, 1, 0); PG8_STAGE(PG8_SA(0, 1), a2 + hstep, voffA);
            PG8_WAIT_L(8); PG8_BAR; PG8_WAIT_L(0); PG8_MMA(0, 0, At, B0); PG8_BAR; PG8_SCHED;
            PG8_LDB(B1, 1, 1); PG8_STAGE(PG8_SB(1, 0), b3, voffB);
            PG8_BAR; PG8_WAIT_L(0); PG8_MMA(0, 1, At, B1); PG8_BAR;
            PG8_LDA(At, 1, 1); PG8_STAGE(PG8_SA(1, 0), a3, voffA);
            PG8_BAR; PG8_WAIT_L(0); PG8_MMA(1, 0, At, B0); PG8_BAR; PG8_SCHED;
            PG8_STAGE(PG8_SB(1, 1), b3 + hstep, voffB);
            PG8_WAIT_V(6); PG8_BAR; PG8_MMA(1, 1, At, B1); PG8_BAR;
            }
        }
        if constexpr (ALIGN_EPI) { if (wr == 0) PG8_BAR; }
        if constexpr (!Epi::AFTER_DRAIN) { E(acc, cur, wr, wc, fr, fq); S.done(cur); }
        if (!has_next) break;
#pragma unroll
        for (int a = 0; a < 2; ++a)
#pragma unroll
            for (int b = 0; b < 2; ++b)
#pragma unroll
                for (int m = 0; m < 4; ++m)
#pragma unroll
                    for (int n = 0; n < 2; ++n) acc[a][b][m][n] = (f32x4){0.f, 0.f, 0.f, 0.f};
        cur = nxt; cA = nA; cB = nB; ++ui;
        if constexpr (ALIGN_EPI) { if (wr == 1) PG8_BAR; }
    }
    PG8_WAIT_V(0);
    if constexpr (!ALIGN_EPI) { if (wr == 0) PG8_BAR; }
    PG8_BAR;
    if constexpr (Epi::AFTER_DRAIN) { E.fused(acc, cur, wr, wc, fr, fq, lds, wid, lane); S.done(cur); }
#undef PG8_SA
#undef PG8_SB
#undef PG8_STAGE
#undef PG8_LDA
#undef PG8_LDB
#undef PG8_MMA
#undef PG8_WAIT_V
#undef PG8_WAIT_L
#undef PG8_BAR
#undef PG8_SCHED
}
}

constexpr int D = 1024, NBATCH = 8, SEQ = 2048, DBATCH = 128, DSEQ = 4;
constexpr int MP = NBATCH * SEQ, MS = DBATCH * DSEQ, M = MP + MS;
constexpr int QAW = 512, KVW = 128, HDA = 64, DMW = 512, HDM = 128, WIN = 128;
constexpr int DFF = 2816, F2 = 5632, PLE = 256, DIN = 4872;
constexpr int N1 = 4864;
constexpr float EPS = 1e-6f;
constexpr float LOG2E = 1.4426950408889634f;
constexpr size_t O_Y = 0, O_WKP = (size_t)M * D, O_WVP = O_WKP + 131072, O_CP = O_WVP + 131072, O_NP = O_CP + 524288, O_MP = O_NP + 4096, O_CONVP = O_MP + 32,
                 O_WKS = O_CONVP + 90112, O_WVS = O_WKS + 2097152, O_CS = O_WVS + 2097152, O_NS = O_CS + 8388608, O_MS = O_NS + 65536, O_CONVS = O_MS + 512, O_END = O_CONVS + 1441792;
static_assert(O_END == 32272928, "output size");
constexpr size_t WS_CTL = 0, CTL_ZERO_BYTES = 1u << 20;
constexpr size_t WS_WIN = CTL_ZERO_BYTES, WS_WOA = WS_WIN + (size_t)N1 * D * 2, WS_WOM = WS_WOA + (size_t)D * QAW * 2, WS_WOUT = WS_WOM + (size_t)D * DMW * 2, WS_WUP = WS_WOUT + (size_t)D * D * 2,
                 WS_WDN = WS_WUP + (size_t)F2 * D * 2, WS_WPLE = WS_WDN + (size_t)D * DFF * 2, WS_WG = WS_WPLE + (size_t)D * PLE * 2;
constexpr size_t WS_BUFA = WS_WG + (size_t)D * D * 2;
constexpr size_t WS_PB = WS_BUFA + (size_t)M * D * 2;
constexpr size_t WS_IG = WS_PB + (size_t)M * PLE * 2, WS_LF = WS_IG + (size_t)M * 16, WS_SS = WS_LF + (size_t)M * 16;
constexpr size_t WS_SSS = WS_SS + (size_t)M * 64;
constexpr size_t WS_RS = WS_SSS + (size_t)MS * 128;
constexpr size_t WS_Z = WS_RS + (size_t)M * 4;
constexpr size_t ZS512 = (size_t)M * 512 * 2, ZS128 = (size_t)M * 128 * 2, ZS1024 = (size_t)M * 1024 * 2;
constexpr size_t Z_QA = 0, Z_KA = Z_QA + ZS512, Z_VA = Z_KA + ZS128, Z_QM = Z_VA + ZS128, Z_KM = Z_QM + ZS512, Z_VM = Z_KM + ZS512, Z_OM = Z_VM + ZS512, Z_GA = Z_OM + ZS512, Z_GM = Z_GA + ZS1024, Z_END = Z_GM + ZS1024;
constexpr size_t WS_END = WS_Z + Z_END;
constexpr size_t Z_MIXED = Z_KM, Z_ACT = Z_QA, Z_TPLE = Z_GA, Z_UB = Z_GM;
constexpr size_t Z_GAU = Z_GA, Z_GMU = Z_GA + ZS512;
static_assert(Z_GA - Z_QA == (size_t)M * DFF * 2, "ACT overlay fits exactly");
static_assert((size_t)(MP / 64) * 4 * F2 * 4 <= ZS1024, "UB fits in GM");
constexpr size_t WS_YH = WS_Z + Z_GM;
constexpr size_t WS_MS = WS_END, MS_DC = 0, MS_DN = (size_t)256 * 16384 * 2, MS_DS = MS_DN + (size_t)256 * 128 * 4, WS_TOTAL = WS_MS + MS_DS + 4096;
static_assert(WS_TOTAL <= (size_t)256 << 20, "workspace");

namespace ep {
using pg8::f32x4; using pg8::u32x4; using pg8::bf16_t; using pg8::Unit; using pg8::BM; using pg8::HALF;
typedef unsigned u32x2 __attribute__((ext_vector_type(2)));
typedef float f32x2_t __attribute__((ext_vector_type(2))); typedef __bf16 bf16x2_t __attribute__((ext_vector_type(2)));
__device__ __forceinline__ unsigned pk2(float lo, float hi) { f32x2_t v = {lo, hi}; bf16x2_t b = __builtin_convertvector(v, bf16x2_t); return __builtin_bit_cast(unsigned, b); }
__device__ __forceinline__ float lo16(unsigned w) { return __uint_as_float(w << 16); }
__device__ __forceinline__ float hi16(unsigned w) { return __uint_as_float(w & 0xffff0000u); }
__device__ __forceinline__ f32x4 unpk4(u32x2 w) { return (f32x4){lo16(w.x), hi16(w.x), lo16(w.y), hi16(w.y)}; }
__device__ __forceinline__ u32x2 pk4(f32x4 v) { return (u32x2){pk2(v[0], v[1]), pk2(v[2], v[3])}; }
__device__ __forceinline__ float sigm(float x) { return __builtin_amdgcn_rcpf(1.0f + __builtin_amdgcn_exp2f(-LOG2E * x)); }
__device__ __forceinline__ f32x4 sigm4(f32x4 v) {
    const f32x4 a = v * (-LOG2E);
    const f32x4 d = (f32x4){__builtin_amdgcn_exp2f(a[0]), __builtin_amdgcn_exp2f(a[1]), __builtin_amdgcn_exp2f(a[2]), __builtin_amdgcn_exp2f(a[3])} + 1.0f;
    return (f32x4){__builtin_amdgcn_rcpf(d[0]), __builtin_amdgcn_rcpf(d[1]), __builtin_amdgcn_rcpf(d[2]), __builtin_amdgcn_rcpf(d[3])};
}
__device__ __forceinline__ float gelu_t(float x) { const float z2 = x * (1.0f + 0.044715f * x * x) * (2.0f * 0.7978845608028654f * LOG2E); return x * __builtin_amdgcn_rcpf(1.0f + __builtin_amdgcn_exp2f(-z2)); }

__device__ __forceinline__ float sum_fq(float q) {
    q += __builtin_bit_cast(float, __builtin_amdgcn_ds_swizzle(__builtin_bit_cast(int, q), 0x401F));
    float a = q, b = q;
    asm volatile("s_nop 1\n\tv_permlane32_swap_b32 %0, %1\n\ts_nop 1" : "+v"(a), "+v"(b));
    return a + b;
}
typedef float f32x2_t __attribute__((ext_vector_type(2)));
__device__ __forceinline__ f32x2_t gelu_t2(f32x2_t x) {
    constexpr float C0 = -2.0f * 0.7978845608028654f * LOG2E, C1 = C0 * 0.044715f;
    const f32x2_t a = x * (x * x * C1 + C0);
    const f32x2_t d = (f32x2_t){__builtin_amdgcn_exp2f(a[0]), __builtin_amdgcn_exp2f(a[1])} + 1.0f;
    return x * (f32x2_t){__builtin_amdgcn_rcpf(d[0]), __builtin_amdgcn_rcpf(d[1])};
}
__device__ __forceinline__ f32x4 gelu_t4(f32x4 x) { const f32x2_t lo = gelu_t2((f32x2_t){x[0], x[1]}), hi = gelu_t2((f32x2_t){x[2], x[3]}); return (f32x4){lo[0], lo[1], hi[0], hi[1]}; }
__device__ __forceinline__ float ror1(float x) { return __builtin_bit_cast(float, __builtin_amdgcn_update_dpp(0, __builtin_bit_cast(int, x), 0x121, 0xf, 0xf, false)); }
__device__ __forceinline__ float ror2(float x) { return __builtin_bit_cast(float, __builtin_amdgcn_update_dpp(0, __builtin_bit_cast(int, x), 0x122, 0xf, 0xf, false)); }
__device__ __forceinline__ float shr1(float x) { return __builtin_bit_cast(float, __builtin_amdgcn_update_dpp(0, __builtin_bit_cast(int, x), 0x111, 0xf, 0xf, true)); }
__device__ __forceinline__ f32x4 ror1v(f32x4 v) { return (f32x4){ror1(v[0]), ror1(v[1]), ror1(v[2]), ror1(v[3])}; }
__device__ __forceinline__ f32x4 ror2v(f32x4 v) { return (f32x4){ror2(v[0]), ror2(v[1]), ror2(v[2]), ror2(v[3])}; }
__device__ __forceinline__ unsigned q8(f32x4 v) { const f32x4 s = v * 255.0f + 0.5f; return (unsigned)s[0] | ((unsigned)s[1] << 8) | ((unsigned)s[2] << 16) | ((unsigned)s[3] << 24); }
__device__ __forceinline__ f32x4 dq8(unsigned w) { return (f32x4){(float)(w & 255u), (float)((w >> 8) & 255u), (float)((w >> 16) & 255u), (float)(w >> 24)} * (1.0f / 255.0f); }
struct EpiZ {
    static constexpr bool PERM = true, AFTER_DRAIN = false, PERMA = false; static constexpr int MIDT = 0;
    unsigned char* z;
    template <int OP> __device__ __forceinline__ void run(const f32x4 (&acc)[2][2][4][2], bf16_t* p0, bf16_t* p1, int ld, int row0, int cw) const {
#pragma unroll
        for (int ai = 0; ai < 2; ++ai)
#pragma unroll
            for (int m = 0; m < 4; ++m) { const unsigned ro = (unsigned)((row0 + ai * HALF + m * 16) * ld + cw) * 2u;
#pragma unroll
                for (int bj = 0; bj < 2; ++bj) { f32x4 v0 = acc[ai][bj][m][0], v1 = acc[ai][bj][m][1];
                    if (OP == 1) { v0 = v0 * 0.08838834764831845f; v1 = v1 * 0.08838834764831845f; }
                    if (OP >= 2) { v0 = sigm4(v0); v1 = sigm4(v1); }
                    if (OP == 3) { *(u32x2*)((unsigned char*)(bj ? p1 : p0) + (unsigned)((row0 + ai * HALF + m * 16) * 1024 + cw)) = (u32x2){q8(v0), q8(v1)}; }
                    else { u32x4 w; w.x = pk2(v0[0], v0[1]); w.y = pk2(v0[2], v0[3]); w.z = pk2(v1[0], v1[1]); w.w = pk2(v1[2], v1[3]); *(u32x4*)((unsigned char*)(bj ? p1 : p0) + ro) = w; } } }
    }
    __device__ __forceinline__ void operator()(const f32x4 (&acc)[2][2][4][2], const Unit& u, int wr, int wc, int fr, int fq) const {
        const int pn = u.pn; bf16_t* p0; bf16_t* p1; int ld; int op = 0;
        if (pn < 2)       { ld = 512; p0 = (bf16_t*)(z + Z_QA) + 256 * pn; p1 = p0 + 128; }
        else if (pn == 2) { ld = 128; p0 = (bf16_t*)(z + Z_KA); p1 = (bf16_t*)(z + Z_VA); }
        else if (pn < 11) { const int t = (pn - 3) >> 1, hs = (pn - 3) & 1; ld = 512; p0 = (bf16_t*)(z + Z_QM + (size_t)t * ZS512) + 256 * hs; p1 = p0 + 128; op = (t == 3) ? 2 : ((t == 1) ? 1 : 0); }
        else              { const int t = (pn - 11) >> 2, q = (pn - 11) & 3; ld = 1024; p0 = (bf16_t*)(z + Z_GAU + (size_t)t * ZS512) + 128 * q; p1 = p0 + 64; op = 3; }
        const int row0 = u.pm * BM + wr * 64 + fr, cw = wc * 32 + 8 * fq;
        if (op == 0) run<0>(acc, p0, p1, ld, row0, cw); else if (op == 1) run<1>(acc, p0, p1, ld, row0, cw); else if (op == 2) run<2>(acc, p0, p1, ld, row0, cw); else run<3>(acc, p0, p1, ld, row0, cw);
    }
};
struct EpiMixK {
    static constexpr bool PERM = true, AFTER_DRAIN = false, PERMA = false; static constexpr int MIDT = 8;
    const unsigned char* ga; const unsigned char* gm; bf16_t* out;
    __device__ __forceinline__ void mid(f32x4 (&acc)[2][2][4][2], const Unit& u, int wr, int wc, int fr_, int fq) const {
        int fr = fr_; asm volatile("" : "+v"(fr));
        const int row0 = u.pm * BM + wr * 64 + fr, col0 = u.pn * BM + wc * 32 + 8 * fq;
#pragma unroll
        for (int ai = 0; ai < 2; ++ai) {
            u32x2 a[4][2], b[4][2];
#pragma unroll
            for (int m = 0; m < 4; ++m)
#pragma unroll
                for (int bj = 0; bj < 2; ++bj) { const size_t off = (size_t)(row0 + ai * HALF + m * 16) * D + col0 + bj * HALF; a[m][bj] = *(const u32x2*)(ga + off); b[m][bj] = *(const u32x2*)(gm + off); }
#pragma unroll
            for (int m = 0; m < 4; ++m)
#pragma unroll
                for (int bj = 0; bj < 2; ++bj) { const f32x4 a0 = dq8(a[m][bj].x), a1 = dq8(a[m][bj].y), b0 = dq8(b[m][bj].x), b1 = dq8(b[m][bj].y);
                    const f32x4 r0 = (f32x4){a0[0] * __builtin_amdgcn_rcpf(fmaxf(b0[0], 1e-20f)), a0[1] * __builtin_amdgcn_rcpf(fmaxf(b0[1], 1e-20f)), a0[2] * __builtin_amdgcn_rcpf(fmaxf(b0[2], 1e-20f)), a0[3] * __builtin_amdgcn_rcpf(fmaxf(b0[3], 1e-20f))};
                    const f32x4 r1 = (f32x4){a1[0] * __builtin_amdgcn_rcpf(fmaxf(b1[0], 1e-20f)), a1[1] * __builtin_amdgcn_rcpf(fmaxf(b1[1], 1e-20f)), a1[2] * __builtin_amdgcn_rcpf(fmaxf(b1[2], 1e-20f)), a1[3] * __builtin_amdgcn_rcpf(fmaxf(b1[3], 1e-20f))};
                    acc[ai][bj][m][0] = acc[ai][bj][m][0] * r0; acc[ai][bj][m][1] = acc[ai][bj][m][1] * r1; }
        }
    }
    __device__ __forceinline__ void operator()(const f32x4 (&acc)[2][2][4][2], const Unit& u, int wr, int wc, int fr, int fq) const {
        const int row0 = u.pm * BM + wr * 64 + fr, col0 = u.pn * BM + wc * 32 + 8 * fq;
        u32x2 ball[2][4][2];
#pragma unroll
        for (int ai = 0; ai < 2; ++ai)
#pragma unroll
            for (int m = 0; m < 4; ++m)
#pragma unroll
                for (int bj = 0; bj < 2; ++bj) ball[ai][m][bj] = *(const u32x2*)(gm + (size_t)(row0 + ai * HALF + m * 16) * D + col0 + bj * HALF);
#pragma unroll
        for (int ai = 0; ai < 2; ++ai) {
            const u32x2 (&b)[4][2] = ball[ai];
#pragma unroll
            for (int m = 0; m < 4; ++m)
#pragma unroll
                for (int bj = 0; bj < 2; ++bj) { const size_t off = (size_t)(row0 + ai * HALF + m * 16) * D + col0 + bj * HALF; const f32x4 b0 = dq8(b[m][bj].x), b1 = dq8(b[m][bj].y);
                    const f32x4 v0 = acc[ai][bj][m][0] * (f32x4){fmaxf(b0[0], 1e-20f), fmaxf(b0[1], 1e-20f), fmaxf(b0[2], 1e-20f), fmaxf(b0[3], 1e-20f)};
                    const f32x4 v1 = acc[ai][bj][m][1] * (f32x4){fmaxf(b1[0], 1e-20f), fmaxf(b1[1], 1e-20f), fmaxf(b1[2], 1e-20f), fmaxf(b1[3], 1e-20f)};
                    u32x4 w; w.x = pk2(v0[0], v0[1]); w.y = pk2(v0[2], v0[3]); w.z = pk2(v1[0], v1[1]); w.w = pk2(v1[2], v1[3]);
                    *(u32x4*)(out + off) = w; }
        }
    }
};
struct EpiX1 {
    static constexpr bool PERM = true, AFTER_DRAIN = false, PERMA = false; static constexpr int MIDT = 0;
    const float* irs; const float* gmix; bf16_t* xb; float* ss;
    __device__ __forceinline__ void operator()(const f32x4 (&acc)[2][2][4][2], const Unit& u, int wr, int wc, int fr, int fq) const {
        const int row0 = u.pm * BM + wr * 64 + fr, col0 = u.pn * BM + wc * 32 + 8 * fq;
        f32x4 ig[2][2];
#pragma unroll
        for (int bj = 0; bj < 2; ++bj)
#pragma unroll
            for (int n = 0; n < 2; ++n) { const f32x4 g = *(const f32x4*)(gmix + col0 + bj * HALF + 4 * n); ig[bj][n] = (f32x4){__builtin_amdgcn_rcpf(g[0]), __builtin_amdgcn_rcpf(g[1]), __builtin_amdgcn_rcpf(g[2]), __builtin_amdgcn_rcpf(g[3])}; }
#pragma unroll
        for (int ai = 0; ai < 2; ++ai) {
            u32x4 r[4][2]; float rr[4];
#pragma unroll
            for (int m = 0; m < 4; ++m) { const int row = row0 + ai * HALF + m * 16; rr[m] = irs[row];
#pragma unroll
                for (int bj = 0; bj < 2; ++bj) r[m][bj] = *(const u32x4*)(xb + (size_t)row * D + col0 + bj * HALF); }
#pragma unroll
            for (int m = 0; m < 4; ++m) { const int row = row0 + ai * HALF + m * 16; float q = 0.f;
#pragma unroll
                for (int bj = 0; bj < 2; ++bj) { const u32x4 xw = r[m][bj];
                    const f32x4 v0 = (f32x4){lo16(xw.x), hi16(xw.x), lo16(xw.y), hi16(xw.y)} * ig[bj][0] * rr[m] + acc[ai][bj][m][0], v1 = (f32x4){lo16(xw.z), hi16(xw.z), lo16(xw.w), hi16(xw.w)} * ig[bj][1] * rr[m] + acc[ai][bj][m][1];
                    u32x4 w; w.x = pk2(v0[0], v0[1]); w.y = pk2(v0[2], v0[3]); w.z = pk2(v1[0], v1[1]); w.w = pk2(v1[2], v1[3]);
                    *(u32x4*)(xb + (size_t)row * D + col0 + bj * HALF) = w;
                    q += ((v0[0] * v0[0] + v0[1] * v0[1]) + (v0[2] * v0[2] + v0[3] * v0[3])) + ((v1[0] * v1[0] + v1[1] * v1[1]) + (v1[2] * v1[2] + v1[3] * v1[3])); }
                q += __shfl_xor(q, 16); q += __shfl_xor(q, 32);
                ss[(size_t)row * 16 + u.pn * 4 + wc] = q; }
        }
    }
};
template <bool DRY = false> struct EpiX2 {
    static constexpr bool PERM = true, AFTER_DRAIN = false, PERMA = false; static constexpr int MIDT = 0;
    bf16_t* xb;
    __device__ __forceinline__ void operator()(const f32x4 (&acc)[2][2][4][2], const Unit& u, int wr, int wc, int fr, int fq) const {
        const int row0 = u.pm * BM + wr * 64 + fr, col0 = u.pn * BM + wc * 32 + 8 * fq;
        u32x4 rall[2][4][2];
#pragma unroll
        for (int ai = 0; ai < 2; ++ai)
#pragma unroll
            for (int m = 0; m < 4; ++m)
#pragma unroll
                for (int bj = 0; bj < 2; ++bj) rall[ai][m][bj] = *(const u32x4*)(xb + (size_t)(row0 + ai * HALF + m * 16) * D + col0 + bj * HALF);
#pragma unroll
        for (int ai = 0; ai < 2; ++ai) {
            const u32x4 (&r)[4][2] = rall[ai];
#pragma unroll
            for (int m = 0; m < 4; ++m)
#pragma unroll
                for (int bj = 0; bj < 2; ++bj) { const size_t off = (size_t)(row0 + ai * HALF + m * 16) * D + col0 + bj * HALF; const u32x4 rr = r[m][bj];
                    const f32x4 v0 = (f32x4){lo16(rr.x), hi16(rr.x), lo16(rr.y), hi16(rr.y)} + (DRY ? acc[ai][bj][m][0] * 0.f : acc[ai][bj][m][0]);
                    const f32x4 v1 = (f32x4){lo16(rr.z), hi16(rr.z), lo16(rr.w), hi16(rr.w)} + (DRY ? acc[ai][bj][m][1] * 0.f : acc[ai][bj][m][1]);
                    u32x4 w; w.x = pk2(v0[0], v0[1]); w.y = pk2(v0[2], v0[3]); w.z = pk2(v1[0], v1[1]); w.w = pk2(v1[2], v1[3]);
                    *(u32x4*)(xb + off) = w; }
        }
    }
};
struct EpiT {
    static constexpr bool PERM = false, AFTER_DRAIN = false, PERMA = false; static constexpr int MIDT = 0;
    bf16_t* t;
    __device__ __forceinline__ void operator()(const f32x4 (&acc)[2][2][4][2], const Unit& u, int wr, int wc, int fr, int fq) const {
        const int row0 = u.pm * BM + wr * 64 + fr, col0 = u.pn * BM + wc * 32 + 4 * fq;
#pragma unroll
        for (int ai = 0; ai < 2; ++ai)
#pragma unroll
            for (int m = 0; m < 4; ++m)
#pragma unroll
                for (int bj = 0; bj < 2; ++bj)
#pragma unroll
                    for (int n = 0; n < 2; ++n) { const size_t off = (size_t)(row0 + ai * HALF + m * 16) * D + col0 + bj * HALF + n * 16; *(u32x2*)(t + off) = pk4(acc[ai][bj][m][n]); }
    }
};
template <bool DRY = false> struct EpiY {
    static constexpr bool PERM = true, AFTER_DRAIN = false, PERMA = false; static constexpr int MIDT = 0;
    const bf16_t* xb; float* y; const bf16_t* t;
    __device__ __forceinline__ void operator()(const f32x4 (&acc)[2][2][4][2], const Unit& u, int wr, int wc, int fr, int fq) const {
        const int row0 = u.pm * BM + wr * 64 + fr, col0 = u.pn * BM + wc * 32 + 8 * fq;
#pragma unroll
        for (int ai = 0; ai < 2; ++ai) {
            u32x4 r[4][2], tw[4][2];
#pragma unroll
            for (int m = 0; m < 4; ++m)
#pragma unroll
                for (int bj = 0; bj < 2; ++bj) { const size_t off = (size_t)(row0 + ai * HALF + m * 16) * D + col0 + bj * HALF; r[m][bj] = *(const u32x4*)(xb + off); tw[m][bj] = *(const u32x4*)(t + off); }
#pragma unroll
            for (int m = 0; m < 4; ++m)
#pragma unroll
                for (int bj = 0; bj < 2; ++bj) { const size_t off = (size_t)(row0 + ai * HALF + m * 16) * D + col0 + bj * HALF; const u32x4 rr = r[m][bj], tt = tw[m][bj];
                    f32x4 t0 = (f32x4){lo16(tt.x), hi16(tt.x), lo16(tt.y), hi16(tt.y)}, t1 = (f32x4){lo16(tt.z), hi16(tt.z), lo16(tt.w), hi16(tt.w)};
                    if (DRY) { t0 = t0 * 0.f; t1 = t1 * 0.f; }
                    __builtin_nontemporal_store((f32x4){lo16(rr.x), hi16(rr.x), lo16(rr.y), hi16(rr.y)} + sigm4(acc[ai][bj][m][0]) * t0, (f32x4*)(y + off));
                    __builtin_nontemporal_store((f32x4){lo16(rr.z), hi16(rr.z), lo16(rr.w), hi16(rr.w)} + sigm4(acc[ai][bj][m][1]) * t1, (f32x4*)(y + off + 4)); }
        }
    }
};
struct EpiConv {
    static constexpr bool PERM = true, AFTER_DRAIN = false, PERMA = true; static constexpr int MIDT = 0;
    const float* ss; const float* sss; const float* cw; const float* cb; const float* st; bf16_t* act; float* ub; float* cso; PG8_LAS float* pl;
    __device__ __forceinline__ void operator()(f32x4 (&acc)[2][2][4][2], const Unit& u, int wr, int wc, int fr_, int fq_) const {
        unsigned z_ = 0u; asm volatile("" : "+v"(z_)); int l_ = (int)__builtin_amdgcn_mbcnt_hi(~0u, __builtin_amdgcn_mbcnt_lo(~0u, z_)); asm volatile("" : "+v"(l_));
        const int fr = l_ & 15, fq = l_ >> 4; (void)fr_; (void)fq_;
        const bool sample = u.pm >= MP / BM;
        const int row0 = u.pm * BM + wr * 64 + 4 * fr;
        PG8_LAS float* P = pl + (wr * 4 + wc) * 256;
        const int pl_lane = fq * 16 + fr, pl_kind = pl_lane >> 4, pl_part = pl_lane & 15, pl_ucol = (pl_part < 8 ? 0 : DFF) + u.pn * 128 + wc * 32 + 4 * (pl_part & 7);
        const f32x4 pv4 = (pl_kind < 3) ? *(const f32x4*)(cw + pl_kind * F2 + pl_ucol) : *(const f32x4*)(cb + pl_ucol);
        *(PG8_LAS f32x4*)(P + pl_kind * 64 + pl_part * 4) = pv4;
        float rs[2][4];
        if (!sample) { f32x4 a[2][4];
#pragma unroll
            for (int ai = 0; ai < 2; ++ai)
#pragma unroll
                for (int m = 0; m < 4; ++m) a[ai][m] = *(const f32x4*)((const char*)ss + (unsigned)((row0 + ai * HALF + m) * 16 + 4 * fq) * 4u);
#pragma unroll
            for (int ai = 0; ai < 2; ++ai)
#pragma unroll
                for (int m = 0; m < 4; ++m) rs[ai][m] = (a[ai][m][0] + a[ai][m][1]) + (a[ai][m][2] + a[ai][m][3]);
        } else { f32x4 a[2][4], b2[2][4];
#pragma unroll
            for (int ai = 0; ai < 2; ++ai)
#pragma unroll
                for (int m = 0; m < 4; ++m) { const float* p_ = sss + (size_t)(row0 + ai * HALF + m - MP) * 32 + 8 * fq; a[ai][m] = *(const f32x4*)p_; b2[ai][m] = *(const f32x4*)(p_ + 4); }
#pragma unroll
            for (int ai = 0; ai < 2; ++ai)
#pragma unroll
                for (int m = 0; m < 4; ++m) rs[ai][m] = ((a[ai][m][0] + a[ai][m][1]) + (a[ai][m][2] + a[ai][m][3])) + ((b2[ai][m][0] + b2[ai][m][1]) + (b2[ai][m][2] + b2[ai][m][3]));
        }
#pragma unroll
        for (int ai = 0; ai < 2; ++ai)
#pragma unroll
            for (int m = 0; m < 4; ++m) { float q = rs[ai][m]; q += __shfl_xor(q, 16); q += __shfl_xor(q, 32); rs[ai][m] = __builtin_amdgcn_rsqf(q * (1.0f / D) + EPS); }
#pragma unroll
        for (int ai = 0; ai < 2; ++ai)
#pragma unroll
            for (int m = 0; m < 4; ++m)
#pragma unroll
                for (int bj = 0; bj < 2; ++bj) { acc[ai][bj][m][0] = acc[ai][bj][m][0] * rs[ai][m]; acc[ai][bj][m][1] = acc[ai][bj][m][1] * rs[ai][m]; }
#pragma unroll
        for (int n = 0; n < 2; ++n) {
            const int ja = u.pn * 128 + wc * 32 + 8 * fq + 4 * n;
#pragma unroll
            for (int hb = 1; hb >= 0; --hb) {
                const int uc = hb * DFF + ja;
                const PG8_LAS float* Pq = P + hb * 32 + 8 * fq + 4 * n;
                const f32x4 w0 = *(const PG8_LAS f32x4*)(Pq), w1 = *(const PG8_LAS f32x4*)(Pq + 64), w2 = *(const PG8_LAS f32x4*)(Pq + 128), bb = *(const PG8_LAS f32x4*)(Pq + 192);
#pragma unroll
                for (int ai = 0; ai < 2; ++ai) {
                    const int rowb = row0 + ai * HALF;
                    f32x4 uv[4];
#pragma unroll
                    for (int m = 0; m < 4; ++m) uv[m] = acc[ai][hb][m][n];
                    f32x4 p3, p2;
                    if (!sample) { p3 = (f32x4){shr1(uv[3][0]), shr1(uv[3][1]), shr1(uv[3][2]), shr1(uv[3][3])}; p2 = (f32x4){shr1(uv[2][0]), shr1(uv[2][1]), shr1(uv[2][2]), shr1(uv[2][3])};
                        if ((fr == 0) || (fr == 15)) { const bool e0 = fr == 0;
                            float* o = (float*)((char*)ub + (unsigned)(((rowb >> 6) * 4 + (e0 ? 0 : 2)) * F2 + uc) * 4u);
                            *(f32x4*)(o) = e0 ? uv[0] : uv[2]; *(f32x4*)(o + F2) = e0 ? uv[1] : uv[3]; }
                    } else { const int sq = (rowb - MP) >> 2;
                        p2 = *(const f32x4*)(st + (size_t)(sq * 2 + 0) * F2 + uc); p3 = *(const f32x4*)(st + (size_t)(sq * 2 + 1) * F2 + uc);
                        __builtin_nontemporal_store(uv[2], (f32x4*)(cso + (size_t)(sq * 2 + 0) * F2 + uc)); __builtin_nontemporal_store(uv[3], (f32x4*)(cso + (size_t)(sq * 2 + 1) * F2 + uc)); }
                    f32x4 y[4];
                    y[0] = bb + w0 * p2 + w1 * p3 + w2 * uv[0];
                    y[1] = bb + w0 * p3 + w1 * uv[0] + w2 * uv[1];
                    y[2] = bb + w0 * uv[0] + w1 * uv[1] + w2 * uv[2];
                    y[3] = bb + w0 * uv[1] + w1 * uv[2] + w2 * uv[3];
#pragma unroll
                    for (int m = 0; m < 4; ++m) {
                        if (hb == 1) acc[ai][1][m][n] = y[m];
                        else { const f32x4 yb = acc[ai][1][m][n]; const f32x4 r = gelu_t4(y[m]) * yb;
                            *(u32x2*)((char*)act + (unsigned)((rowb + m) * DFF + ja) * 2u) = pk4(r); }
                    }
                }
            }
        }
    }
};
}
#define GAS __attribute__((address_space(1)))
#define LAS __attribute__((address_space(3)))
typedef unsigned short bf16;
typedef unsigned v4u __attribute__((ext_vector_type(4)));
typedef float f32x4 __attribute__((ext_vector_type(4)));
typedef short bf16x8 __attribute__((ext_vector_type(8)));
typedef GAS unsigned gu32;
typedef GAS unsigned long long gu64;
#define RLX_AGENT __ATOMIC_RELAXED, __HIP_MEMORY_SCOPE_AGENT
#define LDS_WAIT() asm volatile("s_waitcnt lgkmcnt(0)" ::: "memory")
#define VM_WAIT() asm volatile("s_waitcnt vmcnt(0)" ::: "memory")
__device__ __forceinline__ unsigned long long rt() { return __builtin_amdgcn_s_memrealtime(); }

#define XB_TMO      128
#define XB_XCNT(j)  (256  + 64 * (j))
#define XB_XSUB(j)  (1280 + 64 * (j))
#define XB_XGEN(j)  (2304 + 64 * (j))
#define XB_TOP      3328
#define XB_TOPGEN   3392
#define XCD_BAR_WORDS 3456
#define XB_SPIN_CAP (1u << 18)
#ifndef XB_EARLY_WB
#define XB_EARLY_WB 1
#endif

__device__ __forceinline__ unsigned xb_ld(unsigned* p)              { return __hip_atomic_load(p, __ATOMIC_RELAXED, __HIP_MEMORY_SCOPE_AGENT); }
__device__ __forceinline__ unsigned xb_add(unsigned* p, unsigned v) { return __hip_atomic_fetch_add(p, v, __ATOMIC_RELAXED, __HIP_MEMORY_SCOPE_AGENT); }
__device__ __forceinline__ unsigned xb_xcc_id() { return (unsigned)__builtin_amdgcn_s_getreg((3 << 11) | 20) & 0xFu; }
#define XB_SPIN(cond, bar) do { unsigned _sp = 0; while (cond) { __builtin_amdgcn_s_sleep(1); \
    if ((++_sp & 255u) == 0u) { if (xb_ld(&(bar)[XB_TMO])) break; if (_sp > XB_SPIN_CAP) { atomicAdd(&(bar)[XB_TMO], 1u); break; } } } } while (0)

struct XcdBarrier {
    int wave; unsigned* bar; unsigned x;
    volatile LAS unsigned* st;
};

__device__ __forceinline__ bool xb_thread0(int wave) { unsigned z_ = 0u; asm volatile("" : "+v"(z_)); return wave == 0 && __builtin_amdgcn_mbcnt_hi(~0u, __builtin_amdgcn_mbcnt_lo(~0u, z_)) == 0; }
__device__ __forceinline__ XcdBarrier xcd_barrier_post(unsigned* bar, volatile LAS unsigned* st, int wave) {
    XcdBarrier b; b.wave = wave; b.bar = bar; b.x = xb_xcc_id(); b.st = st;
    if (xb_thread0(wave)) (void)xb_add(&bar[XB_XCNT(b.x)], 1u);
    return b;
}
__device__ __forceinline__ void xcd_barrier_complete(unsigned* bar, unsigned x, unsigned& nloc, unsigned& nx) {
    const unsigned G = gridDim.x * gridDim.y * gridDim.z;
    unsigned sum, cnt, mine, sp = 0u;
    for (;;) {
        sum = 0u; cnt = 0u; mine = 0u;
#pragma unroll
        for (unsigned j = 0; j < 16; ++j) { const unsigned c = xb_ld(&bar[XB_XCNT(j)]); sum += c; cnt += (c > 0u) ? 1u : 0u; mine = (j == x) ? c : mine; }
        if (sum == G) break;
        __builtin_amdgcn_s_sleep(1);
        if ((++sp & 255u) == 0u) { if (xb_ld(&bar[XB_TMO])) break; if (sp > XB_SPIN_CAP) { atomicAdd(&bar[XB_TMO], 1u); break; } }
    }
    nloc = mine > 0u ? mine : 1u; nx = cnt > 0u ? cnt : 1u;
}

__device__ __forceinline__ void xcd_barrier(const XcdBarrier& b) {
    asm volatile("s_waitcnt vmcnt(0)" ::: "memory");
    __syncthreads();
    if (xb_thread0(b.wave)) {
        unsigned* bar = b.bar;
        __builtin_amdgcn_s_waitcnt(0);
        unsigned nloc = b.st[0], nx = b.st[1];
        if (nloc == 0u) { xcd_barrier_complete(bar, b.x, nloc, nx); b.st[0] = nloc; b.st[1] = nx; }
        const unsigned old = xb_add(&bar[XB_XSUB(b.x)], 1u);
        const unsigned gen = old / nloc;
        if (XB_EARLY_WB && (old - gen * nloc) * 2u + 1u == nloc - (nloc & 1u ^ 1u)) asm volatile("buffer_wbl2 sc1" ::: "memory");
        if (old + 1u == (gen + 1u) * nloc) {
            __builtin_amdgcn_fence(__ATOMIC_RELEASE, "agent");
            asm volatile("s_waitcnt vmcnt(0)" ::: "memory");
            const unsigned og = xb_add(&bar[XB_TOP], 1u);
            const unsigned tg = og / nx;
            if (og + 1u == (tg + 1u) * nx) xb_add(&bar[XB_TOPGEN], 1u);
            else XB_SPIN(xb_ld(&bar[XB_TOPGEN]) == tg, bar);
            __builtin_amdgcn_fence(__ATOMIC_ACQUIRE, "agent");
            xb_add(&bar[XB_XGEN(b.x)], 1u);
            asm volatile("s_waitcnt vmcnt(0)" ::: "memory");
        } else {
            XB_SPIN(xb_ld(&bar[XB_XGEN(b.x)]) == gen, bar);
            __builtin_amdgcn_fence(__ATOMIC_ACQUIRE, "agent");
            asm volatile("s_waitcnt vmcnt(0)" ::: "memory");
        }
    }
    __syncthreads();
}

__device__ __forceinline__ void split_arrive(const XcdBarrier& b, unsigned* w) {
    asm volatile("s_waitcnt vmcnt(0)" ::: "memory");
    __syncthreads();
    if (xb_thread0(b.wave)) {
        __builtin_amdgcn_s_waitcnt(0);
        unsigned nloc = b.st[0], nx = b.st[1];
        if (nloc == 0u) { xcd_barrier_complete(b.bar, b.x, nloc, nx); b.st[0] = nloc; b.st[1] = nx; }
        const unsigned old = xb_add(&w[64 * b.x], 1u);
        if (old + 1u == nloc) {
            __builtin_amdgcn_fence(__ATOMIC_RELEASE, "agent");
            asm volatile("s_waitcnt vmcnt(0)" ::: "memory");
            const unsigned og = xb_add(&w[64 * 16], 1u);
            if (og + 1u == nx) xb_add(&w[64 * 17], 1u);
        }
    }
}
__device__ __forceinline__ void split_wait(const XcdBarrier& b, unsigned* w) {
    if (xb_thread0(b.wave)) {
        XB_SPIN(xb_ld(&w[64 * 17]) == 0u, b.bar);
        __builtin_amdgcn_fence(__ATOMIC_ACQUIRE, "agent");
        asm volatile("s_waitcnt vmcnt(0)" ::: "memory");
    }
    __syncthreads();
}

constexpr int NWAVES = 8;
constexpr int RING_OFF = 0, RING_BYTES = 131072;
constexpr int LDSCTL_OFF = RING_BYTES, MISC_OFF = LDSCTL_OFF + 320;
constexpr int PTAB_OFF = LDSCTL_OFF + 512;
constexpr int PARAM_OFF = LDSCTL_OFF + 1024;
constexpr int LDS_BYTES = 147456;
constexpr int CW_TMO = 0, CW_BAR = 4096;
typedef short s16x4 __attribute__((ext_vector_type(4)));
typedef float f32x16 __attribute__((ext_vector_type(16)));
typedef unsigned u32x2 __attribute__((ext_vector_type(2)));
typedef short v4i16_t __attribute__((ext_vector_type(4)));
#define DI __device__ __forceinline__
using ep::pk2; using ep::lo16; using ep::hi16; using ep::sigm;

struct Frame {
    LAS unsigned char* lds;
    volatile LAS unsigned* MISC;
    gu32* ctl;
    int wave, G, bid;
    float* out; unsigned char* ws;
};
DI const float* inp(const Frame& F, int i) { const LAS unsigned* t = (const LAS unsigned*)(F.lds + PTAB_OFF) + 2 * i; const unsigned lo = __builtin_amdgcn_readfirstlane(t[0]), hi = __builtin_amdgcn_readfirstlane(t[1]);
    return (const float*)(const GAS float*)(((unsigned long long)hi << 32) | (unsigned long long)lo); }
DI int lane_fresh() { unsigned z_ = 0u; asm volatile("" : "+v"(z_)); int l = __builtin_amdgcn_mbcnt_hi(~0u, __builtin_amdgcn_mbcnt_lo(~0u, z_)); asm volatile("" : "+v"(l)); return l; }
DI float wave_sum(float v) {
#pragma unroll
    for (int o = 1; o < 64; o <<= 1) v += __shfl_xor(v, o);
    return v;
}
DI void unpack8(v4u w, float (&f)[8]) { f[0] = lo16(w.x); f[1] = hi16(w.x); f[2] = lo16(w.y); f[3] = hi16(w.y); f[4] = lo16(w.z); f[5] = hi16(w.z); f[6] = lo16(w.w); f[7] = hi16(w.w); }
DI v4u pack8(const float (&f)[8]) { v4u w; w.x = pk2(f[0], f[1]); w.y = pk2(f[2], f[3]); w.z = pk2(f[4], f[5]); w.w = pk2(f[6], f[7]); return w; }
DI f32x16 mfma32(bf16x8 a, bf16x8 b, f32x16 c) { return __builtin_amdgcn_mfma_f32_32x32x16_bf16(a, b, c, 0, 0, 0); }
DI s16x4 trd(const LAS bf16* p) { return __builtin_bit_cast(s16x4, __builtin_amdgcn_ds_read_tr16_b64_v4i16((LAS v4i16_t*)p)); }
DI int crow(int reg, int h) { return (reg & 3) + 8 * (reg >> 2) + 4 * h; }
DI bf16x8 cat8(s16x4 lo, s16x4 hi) { return __builtin_shufflevector(lo, hi, 0, 1, 2, 3, 4, 5, 6, 7); }
DI bf16x8 frag_t(const LAS bf16* X, int ld, int k0, int n0, int lane) {
    const int g = lane >> 4, q = (lane & 15) >> 2, p = lane & 3;
    const LAS bf16* a = X + (k0 + 8 * (g >> 1) + q) * ld + n0 + 16 * (g & 1) + 4 * p;
    return cat8(trd(a), trd(a + 4 * ld));
}
DI bf16x8 frag_tp(const LAS bf16* X, int ld, int k0, int n0, int lane) {
    const int g = lane >> 4, q = (lane & 15) >> 2, p = lane & 3;
    const LAS bf16* a = X + (k0 + 4 * (g >> 1) + q) * ld + n0 + 16 * (g & 1) + 4 * p;
    return cat8(trd(a), trd(a + 8 * ld));
}
DI bf16x8 packacc(const f32x16& x, int s) {
    v4u w; w.x = pk2(x[8 * s + 0], x[8 * s + 1]); w.y = pk2(x[8 * s + 2], x[8 * s + 3]); w.z = pk2(x[8 * s + 4], x[8 * s + 5]); w.w = pk2(x[8 * s + 6], x[8 * s + 7]);
    return __builtin_bit_cast(bf16x8, w);
}

template <bool SCALE> DI void p0_transpose_item(const float* W, int ldw, int src_col0, int K, bf16* WT, int dst_row0, int k0, const float* kscale, LAS float* scr, int lane) {
    float wv_[32];
#pragma unroll
    for (int i = 0; i < 32; ++i) wv_[i] = __builtin_nontemporal_load(W + (size_t)(k0 + 2 * i + (lane >> 5)) * ldw + src_col0 + (lane & 31));
    float ks_[32];
    if (SCALE) {
#pragma unroll
        for (int i = 0; i < 32; ++i) ks_[i] = kscale[k0 + 2 * i + (lane >> 5)]; }
#pragma unroll
    for (int i = 0; i < 32; ++i) { const int kk = 2 * i + (lane >> 5); float v = wv_[i]; if (SCALE) v *= ks_[i]; scr[kk * 33 + (lane & 31)] = v; }
    LDS_WAIT(); asm volatile("" ::: "memory");
    const int c = lane & 7;
#pragma unroll
    for (int j = 0; j < 4; ++j) { const int n = (lane >> 3) + 8 * j; const LAS float* s = scr + (8 * c) * 33 + n;
        v4u o; o.x = pk2(s[0 * 33], s[1 * 33]); o.y = pk2(s[2 * 33], s[3 * 33]); o.z = pk2(s[4 * 33], s[5 * 33]); o.w = pk2(s[6 * 33], s[7 * 33]);
        *(GAS v4u*)(WT + (size_t)(dst_row0 + n) * K + k0 + 8 * c) = o; }
    LDS_WAIT(); asm volatile("" ::: "memory");
}
constexpr int I_IN = 16 * (N1 / 32), I_OA = 8 * 32, I_OUT = 16 * 32, I_UP = 16 * (F2 / 32), I_DN = (DFF / 64) * 32, I_PLE = 4 * 32, I_G = 16 * 32;
constexpr int NITEMS = I_IN + 2 * I_OA + I_OUT + I_UP + I_DN + I_PLE + I_G;
DI void p0_weight_items(Frame& F, int it0, int it1) {
    const int lane = lane_fresh();
    const int gw = F.bid * NWAVES + F.wave, NGW = F.G * NWAVES;
    unsigned char* ws = F.ws;
    {
        LAS float* scr = (LAS float*)(F.lds + RING_OFF + F.wave * 8704);
        for (int it = it0 + gw; it < it1; it += NGW) {
            int r = it; const float* W; int ldw, src, K, dst, k0; bf16* WT; bool scaled = false;
            if (r < I_IN) { const int nb = r % (N1 / 32), kb = r / (N1 / 32), n0 = nb * 32; W = inp(F, 11); ldw = DIN; src = n0 < 2816 ? n0 : n0 + 8; K = D; WT = (bf16*)(ws + WS_WIN); dst = n0; k0 = kb * 64; }
            else if ((r -= I_IN) < I_OA) { W = inp(F, 18); ldw = D; src = (r % 32) * 32; K = D; WT = (bf16*)(ws + WS_WOA); dst = src; k0 = (r / 32) * 64; }
            else if ((r -= I_OA) < I_OA) { W = inp(F, 19) - (size_t)QAW * D; ldw = D; src = (r % 32) * 32; K = D; WT = (bf16*)(ws + WS_WOA); dst = src; k0 = QAW + (r / 32) * 64; }
            else if ((r -= I_OA) < I_OUT) { W = inp(F, 20); ldw = D; src = (r % 32) * 32; K = D; WT = (bf16*)(ws + WS_WOUT); dst = src; k0 = (r / 32) * 64; }
            else if ((r -= I_OUT) < I_UP) { const int nb = r % (F2 / 32), kb = r / (F2 / 32), n0 = nb * 32, tile = n0 >> 8, within = n0 & 255;
                W = inp(F, 22); ldw = F2; src = within < 128 ? tile * 128 + within : DFF + tile * 128 + (within - 128); K = D; WT = (bf16*)(ws + WS_WUP); dst = n0; k0 = kb * 64; scaled = true; }
            else if ((r -= I_UP) < I_DN) { W = inp(F, 25); ldw = D; src = (r % 32) * 32; K = DFF; WT = (bf16*)(ws + WS_WDN); dst = src; k0 = (r / 32) * 64; }
            else if ((r -= I_DN) < I_PLE) { W = inp(F, 26); ldw = D; src = (r % 32) * 32; K = PLE; WT = (bf16*)(ws + WS_WPLE); dst = src; k0 = (r / 32) * 64; }
            else { r -= I_PLE; W = inp(F, 27); ldw = D; src = (r % 32) * 32; K = D; WT = (bf16*)(ws + WS_WG); dst = src; k0 = (r / 32) * 64; }
            if (scaled) p0_transpose_item<true>(W, ldw, src, K, WT, dst, k0, inp(F, 21), scr, lane); else p0_transpose_item<false>(W, ldw, src, K, WT, dst, k0, nullptr, scr, lane);
        }
    }
    __syncthreads();
}
DI void p0_prologue(Frame& F) {
    const int lane = lane_fresh(), tid = F.wave * 64 + lane;
    const int gw = F.bid * NWAVES + F.wave, NGW = F.G * NWAVES;
    unsigned char* ws = F.ws;
    p0_weight_items(F, 0, I_IN);
    LAS float* WGt = (LAS float*)(F.lds + RING_OFF);
    { const float* wi = inp(F, 11); float t_[16];
#pragma unroll
      for (int q = 0; q < 16; ++q) { const int i = tid + q * (NWAVES * 64); t_[q] = wi[(size_t)(i >> 3) * DIN + 2816 + (i & 7)]; }
#pragma unroll
      for (int q = 0; q < 16; ++q) { const int i = tid + q * (NWAVES * 64); WGt[(i & 7) * D + (i >> 3)] = t_[q]; } }
    __syncthreads();
    f32x4 g4[4];
#pragma unroll
    for (int j = 0; j < 4; ++j) g4[j] = ((const GAS f32x4*)inp(F, 10))[lane + 64 * j];
    bf16* XN = (bf16*)(ws + WS_BUFA); float* IG = (float*)(ws + WS_IG); float* LF = (float*)(ws + WS_LF); bf16* PB = (bf16*)(ws + WS_PB);
    const float* xP = inp(F, 0); const float* xS = inp(F, 1); const float* pP = inp(F, 8); const float* pS = inp(F, 9);
    const float b_i = inp(F, 12)[lane & 3], b_f = inp(F, 13)[lane & 3];
    f32x4 v[4], vn[4], vnn[4]; f32x4 pv, pvn, pvnn;
#define P0_LOAD(mm, vv, pp) do { if ((mm) < M) { const float* xrow = ((mm) < MP) ? xP + (size_t)(mm) * D : xS + (size_t)((mm) - MP) * D; const float* prow = ((mm) < MP) ? pP + (size_t)(mm) * PLE : pS + (size_t)((mm) - MP) * PLE; \
        _Pragma("unroll") for (int j = 0; j < 4; ++j) vv[j] = __builtin_nontemporal_load((const GAS f32x4*)xrow + lane + 64 * j); pp = __builtin_nontemporal_load((const GAS f32x4*)prow + lane); } } while (0)
    const bool g256_ = (F.G == 256); const int wloc_ = (F.bid >> 3) * NWAVES + F.wave, sidx_ = (F.bid & 7) * 256 + wloc_;
#define P0_ROW(k) (g256_ ? ((k) < 8 ? 2048 * (F.bid & 7) + 256 * (k) + wloc_ : (((k) == 8 && sidx_ < M - MP) ? MP + sidx_ : M)) : ((gw + (k) * NGW < M) ? gw + (k) * NGW : M))
    { const int m0_ = P0_ROW(0), m1_ = P0_ROW(1); P0_LOAD(m0_, v, pv); P0_LOAD(m1_, vn, pvn); }
#pragma unroll 1
    for (int k_ = 0; ; ++k_) { const int m = P0_ROW(k_); if (m >= M) break;
        { const int m2_ = P0_ROW(k_ + 2); P0_LOAD(m2_, vnn, pvnn); }
        float s2 = 0.f;
#pragma unroll
        for (int j = 0; j < 4; ++j) s2 += (v[j].x * v[j].x + v[j].y * v[j].y) + (v[j].z * v[j].z + v[j].w * v[j].w);
        const float irs_ = sqrtf(wave_sum(s2) * (1.0f / D) + EPS), rstd = 1.0f / irs_;
        if (lane == 0) ((float*)(ws + WS_RS))[m] = irs_;
        float gd[8];
#pragma unroll
        for (int c = 0; c < 8; ++c) gd[c] = 0.f;
        GAS unsigned long long* o8 = (GAS unsigned long long*)(XN + (size_t)m * D) + lane;
#pragma unroll
        for (int j = 0; j < 4; ++j) { const f32x4 xn = v[j] * g4[j] * rstd;
            o8[64 * j] = (unsigned long long)pk2(xn.x, xn.y) | ((unsigned long long)pk2(xn.z, xn.w) << 32);
#pragma unroll
            for (int c = 0; c < 8; ++c) { const f32x4 w = *(const LAS f32x4*)(WGt + c * D + 4 * lane + 256 * j); gd[c] += (xn.x * w.x + xn.y * w.y) + (xn.z * w.z + xn.w * w.w); }
            asm volatile("" ::: "memory"); }
#pragma unroll
        for (int c = 0; c < 8; ++c) gd[c] = wave_sum(gd[c]);
        if (lane < 4) { float gi = gd[0], gf = gd[4];
            if (lane == 1) { gi = gd[1]; gf = gd[5]; } else if (lane == 2) { gi = gd[2]; gf = gd[6]; } else if (lane == 3) { gi = gd[3]; gf = gd[7]; }
            IG[(size_t)m * 4 + lane] = gi + b_i;
            const float xf = gf + b_f;
            LF[(size_t)m * 4 + lane] = fminf(xf, 0.f) - log1pf(expf(-fabsf(xf))); }
        ((GAS unsigned long long*)(PB + (size_t)m * PLE))[lane] = (unsigned long long)pk2(pv.x, pv.y) | ((unsigned long long)pk2(pv.z, pv.w) << 32);
#pragma unroll
        for (int j = 0; j < 4; ++j) { v[j] = vn[j]; vn[j] = vnn[j]; }
        pv = pvn; pvn = pvnn;
    }
#undef P0_LOAD
#undef P0_ROW
    __syncthreads();
}

constexpr int LDA = 72;
constexpr int LDM = 136;
constexpr int SC_OFF = 0, GQ_OFF = 5120, T0_OFF = 6144;

DI void attn_chunk(const LAS bf16* Ks, const LAS bf16* Vs, int kb0, const bf16x8 (&qf)[4], int qpos, int nlow, float slope2, float sink2, int lane, f32x16 (&ot)[2], float& inv) {
    const int r = lane & 31, h = lane >> 5;
    asm volatile("" : "+v"(slope2));
    const float base = slope2 * (float)(4 * h), sinkp = sink2 + slope2 * (float)(128 + qpos);
    f32x16 st[5];
#pragma unroll
    for (int kb = 0; kb < 5; ++kb) {
#pragma unroll
        for (int i = 0; i < 16; ++i) st[kb][i] = slope2 * (float)(32 * kb + (i & 3) + 8 * (i >> 2)) + base;
#pragma unroll
        for (int ks = 0; ks < 4; ++ks) { const bf16x8 a = *(const LAS bf16x8*)(Ks + (32 * (kb0 + kb) + r) * LDA + 16 * ks + 8 * h); st[kb] = mfma32(a, qf[ks], st[kb]); }
    }
    { float t_ = st[4][15]; asm volatile("" : "+v"(qpos), "+v"(t_)); st[4][15] = t_; }
#pragma unroll
    for (int i = 0; i < 16; ++i) { const int kk = crow(i, h); if (kk < qpos) st[0][i] = -INFINITY; if (kk > qpos) st[4][i] = -INFINITY; }
#pragma unroll
    for (int kb = 0; kb < 4; ++kb) if (kb < nlow) {
#pragma unroll
        for (int i = 0; i < 16; ++i) st[kb][i] = -INFINITY; }
    float mx = sinkp;
#pragma unroll
    for (int kb = 0; kb < 5; ++kb)
#pragma unroll
        for (int i = 0; i < 16; ++i) mx = fmaxf(mx, st[kb][i]);
    mx = fmaxf(mx, __shfl_xor(mx, 32));
    float sum = 0.f;
#pragma unroll
    for (int kb = 0; kb < 5; ++kb)
#pragma unroll
        for (int i = 0; i < 16; ++i) { const float e = __builtin_amdgcn_exp2f(st[kb][i] - mx); st[kb][i] = e; sum += e; }
    sum += __shfl_xor(sum, 32); sum += __builtin_amdgcn_exp2f(sinkp - mx);
    inv = 1.0f / sum;
#pragma unroll
    for (int db = 0; db < 2; ++db)
#pragma unroll
        for (int i = 0; i < 16; ++i) ot[db][i] = 0.f;
#pragma unroll
    for (int kb = 0; kb < 5; ++kb)
#pragma unroll
        for (int s = 0; s < 2; ++s) { const bf16x8 pf = packacc(st[kb], s);
#pragma unroll
            for (int db = 0; db < 2; ++db) { const bf16x8 vf = frag_tp(Vs, LDA, 32 * (kb0 + kb) + 16 * s, 32 * db, lane); ot[db] = mfma32(vf, pf, ot[db]); } }
}
DI void q_load(const bf16* qp, int lane, v4u (&qw)[4]) {
    const int h = lane >> 5;
#pragma unroll
    for (int ks = 0; ks < 4; ++ks) qw[ks] = *(const GAS v4u*)(qp + 16 * ks + 8 * h);
}
DI void q_norm(const v4u (&qw)[4], const LAS float* gq, int lane, bf16x8 (&qf)[4]) {
    const int h = lane >> 5; float f[4][8]; float s2 = 0.f;
#pragma unroll
    for (int ks = 0; ks < 4; ++ks) { unpack8(qw[ks], f[ks]);
#pragma unroll
        for (int j = 0; j < 8; ++j) s2 += f[ks][j] * f[ks][j]; }
    s2 += __shfl_xor(s2, 32);
    const float sc = (0.125f * LOG2E) / sqrtf(s2 * (1.0f / HDA) + EPS);
#pragma unroll
    for (int ks = 0; ks < 4; ++ks) { float o[8];
#pragma unroll
        for (int j = 0; j < 8; ++j) o[j] = f[ks][j] * sc * gq[16 * ks + 8 * h + j];
        qf[ks] = __builtin_bit_cast(bf16x8, pack8(o)); }
}
DI void attn_store(bf16* op, const f32x16 (&ot)[2], float inv, int h) {
#pragma unroll
    for (int db = 0; db < 2; ++db)
#pragma unroll
        for (int i4 = 0; i4 < 4; ++i4) { u32x2 w; w.x = pk2(ot[db][4 * i4] * inv, ot[db][4 * i4 + 1] * inv); w.y = pk2(ot[db][4 * i4 + 2] * inv, ot[db][4 * i4 + 3] * inv);
            *(GAS u32x2*)(op + 32 * db + 8 * i4 + 4 * h) = w; }
}
DI void attn_prompt_unit(Frame& F, int ui) {
    const int lane = lane_fresh(), tid = F.wave * 64 + lane;
    const int b = ui >> 5, jb = (ui >> 1) & 15, kvh = ui & 1;
    unsigned char* z = F.ws + WS_Z;
    const bf16* QA = (const bf16*)(z + Z_QA); const bf16* KA = (const bf16*)(z + Z_KA); const bf16* VA = (const bf16*)(z + Z_VA);
    LAS bf16* Ks = (LAS bf16*)(F.lds + T0_OFF); LAS bf16* Vs = Ks + 256 * LDA;
    const LAS float* gq = (const LAS float*)(F.lds + GQ_OFF); const LAS float* gk = gq + 64;
    v4u qw0[4], qw1[4];
    { const int r_ = lane & 31, p0 = F.wave * 2, p1 = p0 + 1;
      q_load(QA + (size_t)(b * SEQ + 128 * jb + 32 * (p0 & 3) + r_) * QAW + (kvh * 4 + (p0 >> 2)) * HDA, lane, qw0);
      q_load(QA + (size_t)(b * SEQ + 128 * jb + 32 * (p1 & 3) + r_) * QAW + (kvh * 4 + (p1 >> 2)) * HDA, lane, qw1); }
    v4u kws[4], vws[4];
#pragma unroll
    for (int i = 0; i < 4; ++i) { const int idx = tid + 512 * i, row = idx >> 3, ch = idx & 7, tok = 128 * (jb - 1) + row;
        kws[i] = (v4u){0u, 0u, 0u, 0u}; vws[i] = kws[i];
        if (tok >= 0) { const size_t go = (size_t)(b * SEQ + tok) * KVW + kvh * HDA + 8 * ch; kws[i] = *(const GAS v4u*)(KA + go); vws[i] = *(const GAS v4u*)(VA + go); } }
#pragma unroll
    for (int i = 0; i < 4; ++i) { const int idx = tid + 512 * i, row = idx >> 3, ch = idx & 7; const v4u kw = kws[i], vw = vws[i];
        float kf[8]; unpack8(kw, kf); float s2 = 0.f;
#pragma unroll
        for (int j = 0; j < 8; ++j) s2 += kf[j] * kf[j];
        s2 += __shfl_xor(s2, 1); s2 += __shfl_xor(s2, 2); s2 += __shfl_xor(s2, 4);
        const float rstd = 1.0f / sqrtf(s2 * (1.0f / HDA) + EPS);
#pragma unroll
        for (int j = 0; j < 8; ++j) kf[j] = kf[j] * rstd * gk[8 * ch + j];
        *(LAS v4u*)(Ks + row * LDA + 8 * ch) = pack8(kf); *(LAS v4u*)(Vs + row * LDA + 8 * ch) = vw;
        if (jb == 15 && row >= 128) { const size_t oo = ((size_t)(b * WIN + row - 128) * 2 + kvh) * HDA + 8 * ch; float vf[8]; unpack8(vw, vf);
            __builtin_nontemporal_store((f32x4){kf[0], kf[1], kf[2], kf[3]}, (GAS f32x4*)(F.out + O_WKP + oo)); __builtin_nontemporal_store((f32x4){kf[4], kf[5], kf[6], kf[7]}, (GAS f32x4*)(F.out + O_WKP + oo + 4));
            __builtin_nontemporal_store((f32x4){vf[0], vf[1], vf[2], vf[3]}, (GAS f32x4*)(F.out + O_WVP + oo)); __builtin_nontemporal_store((f32x4){vf[4], vf[5], vf[6], vf[7]}, (GAS f32x4*)(F.out + O_WVP + oo + 4)); }
    }
    __syncthreads();
    const int r = lane & 31, h = lane >> 5;
#pragma unroll 1
    for (int i = 0; i < 2; ++i) { const int pi = F.wave * 2 + i, g = pi >> 2, c = pi & 3, head = kvh * 4 + g;
        bf16x8 qf[4]; if (i == 0) q_norm(qw0, gq, lane, qf); else q_norm(qw1, gq, lane, qf);
        const float slope2 = exp2f(-(float)(head + 1)) * LOG2E, sink2 = inp(F, 16)[head] * LOG2E;
        f32x16 ot[2]; float inv;
        attn_chunk(Ks, Vs, c, qf, r, jb == 0 ? 4 - c : 0, slope2, sink2, lane, ot, inv);
        attn_store((bf16*)(F.ws + WS_YH) + (size_t)(b * SEQ + 128 * jb + 32 * c + r) * D + head * HDA, ot, inv, h);
    }
    __syncthreads();
}
DI void attn_sample_unit(Frame& F, int ui) {
    const int lane = lane_fresh(), tid = F.wave * 64 + lane;
    const int db = ui >> 1, kvh = ui & 1;
    unsigned char* z = F.ws + WS_Z;
    const bf16* QA = (const bf16*)(z + Z_QA); const bf16* KA = (const bf16*)(z + Z_KA); const bf16* VA = (const bf16*)(z + Z_VA);
    LAS bf16* Ks = (LAS bf16*)(F.lds + T0_OFF); LAS bf16* Vs = Ks + 256 * LDA;
    const LAS float* gq = (const LAS float*)(F.lds + GQ_OFF); const LAS float* gk = gq + 64;
    const float* ck = inp(F, 2); const float* cv = inp(F, 3);
    v4u qws[4]; { const int r_ = lane & 15; q_load(QA + (size_t)(MP + db * DSEQ + (r_ & 3)) * QAW + (kvh * 4 + (r_ >> 2)) * HDA, lane, qws); }
    f32x4 kvs[4], vvs[4];
#pragma unroll
    for (int i = 0; i < 4; ++i) { const int idx = tid + 512 * i, row = idx >> 4, c4 = idx & 15; const size_t so = ((size_t)(db * WIN + row) * 2 + kvh) * HDA + 4 * c4; kvs[i] = __builtin_nontemporal_load((const GAS f32x4*)(ck + so)); vvs[i] = __builtin_nontemporal_load((const GAS f32x4*)(cv + so)); }
#pragma unroll
    for (int i = 0; i < 4; ++i) { const int idx = tid + 512 * i, row = idx >> 4, c4 = idx & 15; const f32x4 kv = kvs[i], vv = vvs[i];
        *(LAS u32x2*)(Ks + row * LDA + 4 * c4) = (u32x2){pk2(kv.x, kv.y), pk2(kv.z, kv.w)}; *(LAS u32x2*)(Vs + row * LDA + 4 * c4) = (u32x2){pk2(vv.x, vv.y), pk2(vv.z, vv.w)};
        if (row >= DSEQ) { const size_t oo = ((size_t)(db * WIN + row - DSEQ) * 2 + kvh) * HDA + 4 * c4; __builtin_nontemporal_store(kv, (GAS f32x4*)(F.out + O_WKS + oo)); __builtin_nontemporal_store(vv, (GAS f32x4*)(F.out + O_WVS + oo)); } }
    if (tid < 32) { const int t = tid >> 3, ch = tid & 7; const size_t go = (size_t)(MP + db * DSEQ + t) * KVW + kvh * HDA + 8 * ch;
        const v4u kw = *(const GAS v4u*)(KA + go), vw = *(const GAS v4u*)(VA + go);
        float kf[8]; unpack8(kw, kf); float s2 = 0.f;
#pragma unroll
        for (int j = 0; j < 8; ++j) s2 += kf[j] * kf[j];
        s2 += __shfl_xor(s2, 1); s2 += __shfl_xor(s2, 2); s2 += __shfl_xor(s2, 4);
        const float rstd = 1.0f / sqrtf(s2 * (1.0f / HDA) + EPS);
#pragma unroll
        for (int j = 0; j < 8; ++j) kf[j] = kf[j] * rstd * gk[8 * ch + j];
        *(LAS v4u*)(Ks + (WIN + t) * LDA + 8 * ch) = pack8(kf); *(LAS v4u*)(Vs + (WIN + t) * LDA + 8 * ch) = vw;
        const size_t oo = ((size_t)(db * WIN + WIN - DSEQ + t) * 2 + kvh) * HDA + 8 * ch; float vf[8]; unpack8(vw, vf);
        __builtin_nontemporal_store((f32x4){kf[0], kf[1], kf[2], kf[3]}, (GAS f32x4*)(F.out + O_WKS + oo)); __builtin_nontemporal_store((f32x4){kf[4], kf[5], kf[6], kf[7]}, (GAS f32x4*)(F.out + O_WKS + oo + 4));
        __builtin_nontemporal_store((f32x4){vf[0], vf[1], vf[2], vf[3]}, (GAS f32x4*)(F.out + O_WVS + oo)); __builtin_nontemporal_store((f32x4){vf[4], vf[5], vf[6], vf[7]}, (GAS f32x4*)(F.out + O_WVS + oo + 4));
    } else if (tid < 32 + 252) { const int c = tid - 32; const v4u zz = (v4u){0u, 0u, 0u, 0u};
        *(LAS v4u*)((LAS unsigned char*)(Ks + (WIN + DSEQ) * LDA) + 16 * c) = zz; *(LAS v4u*)((LAS unsigned char*)(Vs + (WIN + DSEQ) * LDA) + 16 * c) = zz; }
    __syncthreads();
    if (F.wave == 0) { const int r = lane & 15, g = r >> 2, t = r & 3, head = kvh * 4 + g, h = lane >> 5;
        bf16x8 qf[4]; q_norm(qws, gq, lane, qf);
        const float slope2 = exp2f(-(float)(head + 1)) * LOG2E, sink2 = inp(F, 16)[head] * LOG2E;
        f32x16 ot[2]; float inv;
        attn_chunk(Ks, Vs, 0, qf, t, 0, slope2, sink2, lane, ot, inv);
        if ((lane & 31) < 16) attn_store((bf16*)(F.ws + WS_YH) + (size_t)(MP + db * DSEQ + t) * D + head * HDA, ot, inv, h);
    }
    __syncthreads();
}
DI void mlstm_scalars(LAS float* sc, const float* LFp, const float* IGp, size_t row0, int hh, int tid) {
    LAS float* sF = sc; LAS float* sB = sc + 256; LAS float* sG = sc + 512; LAS float* red = sc + 1024;
    const int lane = tid & 63, wv = tid >> 6;
    float lf = 0.f, ig = 0.f; if (tid < 256) { lf = LFp[(row0 + tid) * 4 + hh]; ig = IGp[(row0 + tid) * 4 + hh]; }
    float Fv = lf;
#pragma unroll
    for (int o = 1; o < 64; o <<= 1) { const float t = __shfl_up(Fv, o); if (lane >= o) Fv += t; }
    if (tid < 256 && lane == 63) red[wv] = Fv;
    __syncthreads();
    if (wv < 4) for (int j = 0; j < wv; ++j) Fv += red[j];
    const float bv = ig - Fv; float Gv = bv;
#pragma unroll
    for (int o = 1; o < 64; o <<= 1) { const float t = __shfl_up(Gv, o); if (lane >= o) Gv = fmaxf(Gv, t); }
    if (tid < 256 && lane == 63) red[4 + wv] = Gv;
    __syncthreads();
    if (wv < 4) for (int j = 0; j < wv; ++j) Gv = fmaxf(Gv, red[4 + j]);
    if (tid < 256) { sF[tid] = Fv; sB[tid] = bv; sG[tid] = Gv; }
    __syncthreads();
}
DI void mlstm_p1_pre(Frame& F, int ui) {
    const int lane = lane_fresh(), tid = F.wave * 64 + lane;
    const int b = ui >> 5, hh = (ui >> 3) & 3, c = ui & 7;
    const size_t row0 = (size_t)b * SEQ + 256 * c;
    LAS float* sc = (LAS float*)(F.lds + SC_OFF); LAS float* sW = sc + 768;
    mlstm_scalars(sc, (const float*)(F.ws + WS_LF), (const float*)(F.ws + WS_IG), row0, hh, tid);
    const float g255 = sc[512 + 255], FL = sc[255];
    if (tid < 256) sW[tid] = expf(sc[256 + tid] - g255);
    float* DS = (float*)(F.ws + WS_MS + MS_DS); if (tid == 0) { DS[ui * 2] = FL + g255; DS[ui * 2 + 1] = FL; }
    __syncthreads();
}
DI void mlstm_p1_unit(Frame& F, int ui, bool pre) {
    const int lane = lane_fresh(), tid = F.wave * 64 + lane;
    const int b = ui >> 5, hh = (ui >> 3) & 3, c = ui & 7, w = F.wave;
    const size_t row0 = (size_t)b * SEQ + 256 * c;
    unsigned char* z = F.ws + WS_Z; const bf16* KM = (const bf16*)(z + Z_KM); const bf16* VM = (const bf16*)(z + Z_VM);
    LAS float* sc = (LAS float*)(F.lds + SC_OFF); LAS float* sW = sc + 768;
    LAS bf16* Kc = (LAS bf16*)(F.lds + T0_OFF); LAS bf16* Vw = Kc + 128 * LDM;
    v4u kq[2][4], vq[2][4];
#pragma unroll
    for (int half = 0; half < 2; ++half)
#pragma unroll
        for (int i = 0; i < 4; ++i) { const int idx = tid + 512 * i, row = idx >> 4, ch = idx & 15, s = 128 * half + row; const size_t go = (row0 + s) * DMW + hh * HDM + 8 * ch;
            kq[half][i] = *(const GAS v4u*)(KM + go); vq[half][i] = *(const GAS v4u*)(VM + go); }
    if (!pre) {
    mlstm_scalars(sc, (const float*)(F.ws + WS_LF), (const float*)(F.ws + WS_IG), row0, hh, tid);
    const float g255 = sc[512 + 255], FL = sc[255];
    if (tid < 256) sW[tid] = expf(sc[256 + tid] - g255);
    float* DS = (float*)(F.ws + WS_MS + MS_DS); if (tid == 0) { DS[ui * 2] = FL + g255; DS[ui * 2 + 1] = FL; }
    __syncthreads(); }
    f32x16 acc[2];
#pragma unroll
    for (int j = 0; j < 2; ++j)
#pragma unroll
        for (int i = 0; i < 16; ++i) acc[j][i] = 0.f;
    float dn = 0.f;
    const int dblk = w >> 1, eb0 = 2 * (w & 1);
#pragma unroll
    for (int half = 0; half < 2; ++half) {
#pragma unroll
        for (int i = 0; i < 4; ++i) { const int idx = tid + 512 * i, row = idx >> 4, ch = idx & 15, s = 128 * half + row;
            const v4u kw = kq[half][i], vw = vq[half][i]; float vf[8]; unpack8(vw, vf); const float ws_ = sW[s];
#pragma unroll
            for (int j = 0; j < 8; ++j) vf[j] *= ws_;
            *(LAS v4u*)(Kc + row * LDM + 8 * ch) = kw; *(LAS v4u*)(Vw + row * LDM + 8 * ch) = pack8(vf); }
        __syncthreads();
#pragma unroll
        for (int ks = 0; ks < 8; ++ks) { const bf16x8 a = frag_t(Kc, LDM, 16 * ks, 32 * dblk, lane);
#pragma unroll
            for (int j = 0; j < 2; ++j) { const bf16x8 bb = frag_t(Vw, LDM, 16 * ks, 32 * (eb0 + j), lane); acc[j] = mfma32(a, bb, acc[j]); } }
        { const int dcol = tid & 127, dq = tid >> 7;
#pragma unroll 8
          for (int s = 32 * dq; s < 32 * dq + 32; ++s) dn += sW[128 * half + s] * lo16((unsigned)Kc[s * LDM + dcol]); }
        __syncthreads();
    }
    bf16* DC = (bf16*)(F.ws + WS_MS + MS_DC) + (size_t)ui * 16384; float* DN = (float*)(F.ws + WS_MS + MS_DN) + (size_t)ui * 128;
    const int r = lane & 31, h = lane >> 5;
#pragma unroll
    for (int j = 0; j < 2; ++j)
#pragma unroll
        for (int i = 0; i < 16; ++i) Kc[(32 * dblk + crow(i, h)) * LDM + 32 * (eb0 + j) + r] = (bf16)(pk2(acc[j][i], 0.f) & 0xffffu);
    { LAS float* dnp = (LAS float*)Vw; dnp[tid] = dn; }
    __syncthreads();
    if (tid < 128) { const LAS float* dnp = (const LAS float*)Vw; DN[tid] = (dnp[tid] + dnp[tid + 128]) + (dnp[tid + 256] + dnp[tid + 384]); }
#pragma unroll
    for (int i = 0; i < 4; ++i) { const int idx = tid + 512 * i, d = idx >> 4, ch = idx & 15; *(GAS v4u*)(DC + d * 128 + 8 * ch) = *(const LAS v4u*)(Kc + d * LDM + 8 * ch); }
    __syncthreads();
}
DI void mlstm_rowfac(LAS float* sc, int tid) { if (tid < 256) sc[768 + tid] = expf(sc[256 + tid] - sc[512 + (tid | 31)]); }
DI void mlstm_p2_pre(Frame& F, int ui) {
    const int lane = lane_fresh(), tid = F.wave * 64 + lane;
    const int b = ui >> 5, hh = (ui >> 3) & 3, c = ui & 7;
    const size_t row0 = (size_t)b * SEQ + 256 * c;
    unsigned char* z = F.ws + WS_Z; const bf16* KM = (const bf16*)(z + Z_KM); const bf16* VM = (const bf16*)(z + Z_VM);
    LAS float* sc = (LAS float*)(F.lds + SC_OFF);
    LAS bf16* Kc = (LAS bf16*)(F.lds + T0_OFF); LAS bf16* Vc = Kc + 128 * LDM;
    v4u kk[4], vv[4];
#pragma unroll
    for (int i = 0; i < 4; ++i) { const int idx = tid + 512 * i, row = idx >> 4, ch = idx & 15; const size_t go = (row0 + row) * DMW + hh * HDM + 8 * ch; kk[i] = *(const GAS v4u*)(KM + go); vv[i] = *(const GAS v4u*)(VM + go); }
    mlstm_scalars(sc, (const float*)(F.ws + WS_LF), (const float*)(F.ws + WS_IG), row0, hh, tid);
    mlstm_rowfac(sc, tid);
#pragma unroll
    for (int i = 0; i < 4; ++i) { const int idx = tid + 512 * i, row = idx >> 4, ch = idx & 15; *(LAS v4u*)(Kc + row * LDM + 8 * ch) = kk[i]; *(LAS v4u*)(Vc + row * LDM + 8 * ch) = vv[i]; }
    __syncthreads();
}
DI void mlstm_p2_unit(Frame& F, int ui, bool pre) {
    const int lane = lane_fresh(), tid = F.wave * 64 + lane;
    const int b = ui >> 5, hh = (ui >> 3) & 3, c = ui & 7, w = F.wave;
    const size_t row0 = (size_t)b * SEQ + 256 * c;
    unsigned char* z = F.ws + WS_Z; const bf16* QM = (const bf16*)(z + Z_QM); const bf16* KM = (const bf16*)(z + Z_KM); const bf16* VM = (const bf16*)(z + Z_VM); const bf16* OM = (const bf16*)(z + Z_OM);
    LAS float* sc = (LAS float*)(F.lds + SC_OFF);
    LAS bf16* Kc = (LAS bf16*)(F.lds + T0_OFF); LAS bf16* Vc = Kc + 128 * LDM; LAS bf16* Cs = Vc + 128 * LDM; LAS float* ns = (LAS float*)(Cs + 128 * LDM);
    const float* DS = (const float*)(F.ws + WS_MS + MS_DS); const bf16* DCb = (const bf16*)(F.ws + WS_MS + MS_DC); const float* DNb = (const float*)(F.ws + WS_MS + MS_DN);
    const int u0 = ui - c;
    LAS float* gh = ns + 128;
    const int r = lane & 31, h = lane >> 5, t = 32 * w + r;
    const bf16* qp = QM + (row0 + t) * DMW + hh * HDM; bf16* hp = (bf16*)(F.ws + WS_YH) + (row0 + t) * D + DMW + hh * HDM;
    bf16x8 qf[8];
#pragma unroll
    for (int ks = 0; ks < 8; ++ks) qf[ks] = __builtin_bit_cast(bf16x8, *(const GAS v4u*)(qp + 16 * ks + 8 * h));
    const float ghv = inp(F, 17)[hh * HDM + (tid & 127)];
    v4u T[7][4]; float nT[7], Ms[7], FLs[7];
#pragma unroll
    for (int cp = 0; cp < 7; ++cp) { const int us = (cp < c) ? u0 + cp : ui;
#pragma unroll
        for (int i = 0; i < 4; ++i) T[cp][i] = *(const GAS v4u*)(DCb + (size_t)us * 16384 + 8 * (tid + 512 * i));
        nT[cp] = DNb[(size_t)us * 128 + (tid & 127)]; Ms[cp] = DS[us * 2]; FLs[cp] = DS[us * 2 + 1]; }
    if (!pre) { mlstm_scalars(sc, (const float*)(F.ws + WS_LF), (const float*)(F.ws + WS_IG), row0, hh, tid); mlstm_rowfac(sc, tid); }
    if (tid < 128) gh[tid] = ghv;
    v4u T7[4]; float nT7 = 0.f, Ms7 = 0.f, FLs7 = 0.f;
    if (c == 7) {
#pragma unroll
        for (int i = 0; i < 4; ++i) T7[i] = *(const GAS v4u*)(DCb + (size_t)ui * 16384 + 8 * (tid + 512 * i));
        nT7 = (tid < 128) ? DNb[(size_t)ui * 128 + tid] : 0.f; Ms7 = DS[ui * 2]; FLs7 = DS[ui * 2 + 1]; }
    float C[4][8]; float nv = 0.f; float mc = 0.f;
#pragma unroll
    for (int i = 0; i < 4; ++i)
#pragma unroll
        for (int j = 0; j < 8; ++j) C[i][j] = 0.f;
#pragma unroll
    for (int cp = 0; cp < 7; ++cp) if (cp < c) { const float mn = fmaxf(FLs[cp] + mc, Ms[cp]), dec = expf(FLs[cp] + mc - mn), inj = expf(Ms[cp] - mn);
#pragma unroll
        for (int i = 0; i < 4; ++i) { float f[8]; unpack8(T[cp][i], f);
#pragma unroll
            for (int j = 0; j < 8; ++j) C[i][j] = C[i][j] * dec + f[j] * inj; }
        nv = nv * dec + nT[cp] * inj; mc = mn; }
#pragma unroll
    for (int i = 0; i < 4; ++i) { const int idx = 8 * (tid + 512 * i), d = idx >> 7, e = idx & 127; *(LAS v4u*)(Cs + d * LDM + e) = pack8(C[i]); }
    if (tid < 128) ns[tid] = nv;
    if (c == 7) {
        const float mn = fmaxf(FLs7 + mc, Ms7), dec = expf(FLs7 + mc - mn), inj = expf(Ms7 - mn);
        float* dst = F.out + O_CP + (size_t)(b * 4 + hh) * 16384;
#pragma unroll
        for (int i = 0; i < 4; ++i) { float f[8]; unpack8(T7[i], f); const int idx = 8 * (tid + 512 * i);
            __builtin_nontemporal_store((f32x4){C[i][0] * dec + f[0] * inj, C[i][1] * dec + f[1] * inj, C[i][2] * dec + f[2] * inj, C[i][3] * dec + f[3] * inj}, (GAS f32x4*)(dst + idx));
            __builtin_nontemporal_store((f32x4){C[i][4] * dec + f[4] * inj, C[i][5] * dec + f[5] * inj, C[i][6] * dec + f[6] * inj, C[i][7] * dec + f[7] * inj}, (GAS f32x4*)(dst + idx + 4)); }
        if (tid < 128) F.out[O_NP + (size_t)(b * 4 + hh) * 128 + tid] = nv * dec + nT7 * inj;
        if (tid == 0) F.out[O_MP + b * 4 + hh] = mn;
    }
    __syncthreads();
    const float mu = fmaxf(mc, sc[512 + t]), at = expf(mc - mu);
    f32x16 nt[4];
#pragma unroll
    for (int eb = 0; eb < 4; ++eb) {
#pragma unroll
        for (int i = 0; i < 16; ++i) nt[eb][i] = 0.f;
#pragma unroll
        for (int ks = 0; ks < 8; ++ks) { const bf16x8 a = frag_t(Cs, LDM, 16 * ks, 32 * eb, lane); nt[eb] = mfma32(a, qf[ks], nt[eb]); }
#pragma unroll
        for (int i = 0; i < 16; ++i) nt[eb][i] *= at;
    }
    float qn = 0.f;
#pragma unroll
    for (int ks = 0; ks < 8; ++ks) { float f[8]; unpack8(__builtin_bit_cast(v4u, qf[ks]), f);
#pragma unroll
        for (int j = 0; j < 8; ++j) qn += f[j] * ns[16 * ks + 8 * h + j]; }
    qn += __shfl_xor(qn, 32);
    float rowsum = 0.f;
#pragma unroll 1
    for (int half = 0; half < 2; ++half) {
        if (!(pre && half == 0)) {
#pragma unroll
        for (int i = 0; i < 4; ++i) { const int idx = tid + 512 * i, row = idx >> 4, ch = idx & 15, s = 128 * half + row; const size_t go = (row0 + s) * DMW + hh * HDM + 8 * ch;
            *(LAS v4u*)(Kc + row * LDM + 8 * ch) = *(const GAS v4u*)(KM + go); *(LAS v4u*)(Vc + row * LDM + 8 * ch) = *(const GAS v4u*)(VM + go); } }
        __syncthreads();
        if (w >= 4 * half) { const int nblk = (w - 4 * half + 1) < 4 ? (w - 4 * half + 1) : 4;
#pragma unroll 1
            for (int jb = 0; jb < nblk; ++jb) { const int sb = 4 * half + jb;
                const float cf = __builtin_amdgcn_exp2f((sc[512 + 32 * sb + 31] - mu) * LOG2E);
                f32x16 st;
#pragma unroll
                for (int i = 0; i < 16; ++i) st[i] = 0.f;
#pragma unroll
                for (int ks = 0; ks < 8; ++ks) { const bf16x8 a = *(const LAS bf16x8*)(Kc + (32 * jb + r) * LDM + 16 * ks + 8 * h); st = mfma32(a, qf[ks], st); }
                bf16x8 vfa[4], vfb[4];
#pragma unroll
                for (int eb = 0; eb < 4; ++eb) { vfa[eb] = frag_tp(Vc, LDM, 32 * jb, 32 * eb, lane); vfb[eb] = frag_tp(Vc, LDM, 32 * jb + 16, 32 * eb, lane); }
#pragma unroll
                for (int g4 = 0; g4 < 4; ++g4) { const f32x4 R4 = *(const LAS f32x4*)(sc + 768 + 32 * sb + 8 * g4 + 4 * h) * cf;
#pragma unroll
                    for (int e4 = 0; e4 < 4; ++e4) { const int i = 4 * g4 + e4, s = 32 * sb + crow(i, h); const float wv = (s <= t) ? st[i] * R4[e4] : 0.f; st[i] = wv; rowsum += wv; } }
                { const bf16x8 pf = packacc(st, 0);
#pragma unroll
                  for (int eb = 0; eb < 4; ++eb) nt[eb] = mfma32(vfa[eb], pf, nt[eb]); }
                { const bf16x8 pf = packacc(st, 1);
#pragma unroll
                  for (int eb = 0; eb < 4; ++eb) nt[eb] = mfma32(vfb[eb], pf, nt[eb]); }
            } }
        __syncthreads();
    }
    u32x2 omw[4][4];
    { const bf16* op = OM + (row0 + t) * DMW + hh * HDM;
#pragma unroll
      for (int eb = 0; eb < 4; ++eb)
#pragma unroll
          for (int i4 = 0; i4 < 4; ++i4) omw[eb][i4] = *(const GAS u32x2*)(op + 32 * eb + 8 * i4 + 4 * h); }
    rowsum += __shfl_xor(rowsum, 32);
    const float den = at * qn + rowsum, mt = sc[t] + mu, dnm = fmaxf(fabsf(den), expf(-mt)), invd = 1.0f / dnm;
    float s2 = 0.f;
#pragma unroll
    for (int eb = 0; eb < 4; ++eb)
#pragma unroll
        for (int i = 0; i < 16; ++i) { nt[eb][i] *= invd; s2 += nt[eb][i] * nt[eb][i]; }
    s2 += __shfl_xor(s2, 32);
    const float rstd = 1.0f / sqrtf(s2 * (1.0f / HDM) + EPS);
#pragma unroll
    for (int eb = 0; eb < 4; ++eb)
#pragma unroll
        for (int i4 = 0; i4 < 4; ++i4) { const int e = 32 * eb + 8 * i4 + 4 * h; const f32x4 g = *(const LAS f32x4*)(gh + e); const u32x2 ow = omw[eb][i4];
            u32x2 o; o.x = pk2(nt[eb][4 * i4] * rstd * g.x * lo16(ow.x), nt[eb][4 * i4 + 1] * rstd * g.y * hi16(ow.x)); o.y = pk2(nt[eb][4 * i4 + 2] * rstd * g.z * lo16(ow.y), nt[eb][4 * i4 + 3] * rstd * g.w * hi16(ow.y));
            *(GAS u32x2*)(hp + e) = o; }
    __syncthreads();
}
DI void mlstm_sample_c0(Frame& F, int ui, float (&c0v)[32]) {
    const int tid = F.wave * 64 + lane_fresh(), e = tid & 127, qtr = tid >> 7; const float* C0 = inp(F, 4) + (size_t)ui * 16384;
#pragma unroll
    for (int dd = 0; dd < 32; ++dd) c0v[dd] = __builtin_nontemporal_load(C0 + (32 * qtr + dd) * 128 + e);
}
DI void mlstm_sample_unit(Frame& F, int ui, const float (&c0v)[32], int ui_next, float (&c0n)[32]) {
    if (ui_next < 4 * DBATCH) mlstm_sample_c0(F, ui_next, c0n);
    const int lane = lane_fresh(), tid = F.wave * 64 + lane;
    const int db = ui >> 2, hh = ui & 3;
    const size_t row0 = (size_t)MP + db * DSEQ;
    unsigned char* z = F.ws + WS_Z; const bf16* QM = (const bf16*)(z + Z_QM); const bf16* KM = (const bf16*)(z + Z_KM); const bf16* VM = (const bf16*)(z + Z_VM); const bf16* OM = (const bf16*)(z + Z_OM);
    LAS float* sq = (LAS float*)(F.lds + T0_OFF); LAS float* sk = sq + 512; LAS float* sv = sk + 512; LAS float* sqk = sv + 512; LAS float* sqn = sqk + 16; LAS float* sred = sqn + 16; LAS float* red = sred + 16;
    const float* LFp = (const float*)(F.ws + WS_LF); const float* IGp = (const float*)(F.ws + WS_IG);
    const int e = tid & 127, qtr = tid >> 7;
    float* C1 = F.out + O_CS + (size_t)(db * 4 + hh) * 16384;
    { const int t = tid >> 7, dd = tid & 127; const size_t go = (row0 + t) * DMW + hh * HDM + dd; sq[tid] = lo16((unsigned)QM[go]); sk[tid] = lo16((unsigned)KM[go]); sv[tid] = lo16((unsigned)VM[go]); }
    float Fc[4], ig[4]; { float a = 0.f;
#pragma unroll
        for (int t = 0; t < 4; ++t) { a += LFp[(row0 + t) * 4 + hh]; Fc[t] = a; ig[t] = IGp[(row0 + t) * 4 + hh]; } }
    const float m0 = inp(F, 6)[db * 4 + hh]; const float* n0p = inp(F, 5) + (size_t)(db * 4 + hh) * 128;
    const float n0a = n0p[lane], n0b = n0p[64 + lane], n0t = n0p[tid & 127], ghm = inp(F, 17)[hh * HDM + (tid & 127)];
    float omv[4];
#pragma unroll
    for (int t = 0; t < 4; ++t) omv[t] = lo16((unsigned)OM[(row0 + t) * DMW + hh * HDM + (tid & 127)]);
    __syncthreads();
    for (int j = F.wave; j < 20; j += NWAVES) {
        float a;
        if (j < 16) { const int t = j >> 2, s = j & 3; a = sq[t * 128 + lane] * sk[s * 128 + lane] + sq[t * 128 + 64 + lane] * sk[s * 128 + 64 + lane]; }
        else { const int t = j - 16; a = sq[t * 128 + lane] * n0a + sq[t * 128 + 64 + lane] * n0b; }
        a = wave_sum(a);
        if (lane == 0) { if (j < 16) sqk[j] = a; else sqn[j - 16] = a; } }
    float mt[4], ai[4];
#pragma unroll
    for (int t = 0; t < 4; ++t) { float mx = Fc[t] + m0;
#pragma unroll
        for (int s = 0; s < 4; ++s) if (s <= t) mx = fmaxf(mx, Fc[t] - Fc[s] + ig[s]);
        mt[t] = mx; ai[t] = expf(Fc[t] + m0 - mx); }
    const float mnew = mt[3], dec = expf(Fc[3] + m0 - mnew);
    float wsv[4];
#pragma unroll
    for (int s = 0; s < 4; ++s) wsv[s] = expf(Fc[3] - Fc[s] + ig[s] - mnew);
    __syncthreads();
    float ve[4];
#pragma unroll
    for (int s = 0; s < 4; ++s) ve[s] = sv[s * 128 + e];
    float part[4] = {0.f, 0.f, 0.f, 0.f};
#pragma unroll
    for (int dd = 0; dd < 32; ++dd) { const int d = 32 * qtr + dd; const float c0 = c0v[dd]; float c1 = dec * c0;
#pragma unroll
        for (int s = 0; s < 4; ++s) { part[s] += sq[s * 128 + d] * c0; c1 += wsv[s] * sk[s * 128 + d] * ve[s]; }
        __builtin_nontemporal_store(c1, C1 + d * 128 + e); }
#pragma unroll
    for (int t = 0; t < 4; ++t) red[(qtr * 4 + t) * 128 + e] = part[t];
    __syncthreads();
    if (tid < 128) {
        float hv[4]; float s2p[4];
#pragma unroll
        for (int t = 0; t < 4; ++t) { const float inter = (red[(0 * 4 + t) * 128 + e] + red[(1 * 4 + t) * 128 + e]) + (red[(2 * 4 + t) * 128 + e] + red[(3 * 4 + t) * 128 + e]);
            float num = ai[t] * inter, den = ai[t] * sqn[t];
#pragma unroll
            for (int s = 0; s < 4; ++s) if (s <= t) { const float wts = sqk[t * 4 + s] * expf(Fc[t] - Fc[s] + ig[s] - mt[t]); num += wts * ve[s]; den += wts; }
            hv[t] = num / fmaxf(fabsf(den), expf(-mt[t])); s2p[t] = wave_sum(hv[t] * hv[t]); }
        if (lane == 0) {
#pragma unroll
            for (int t = 0; t < 4; ++t) sred[(tid >> 6) * 4 + t] = s2p[t]; }
        float n1 = dec * n0t;
#pragma unroll
        for (int s = 0; s < 4; ++s) n1 += wsv[s] * sk[s * 128 + tid];
        F.out[O_NS + (size_t)(db * 4 + hh) * 128 + tid] = n1;
        if (tid == 0) F.out[O_MS + db * 4 + hh] = mnew;
        asm volatile("s_waitcnt lgkmcnt(0)" ::: "memory");
#pragma unroll
        for (int t = 0; t < 4; ++t) red[t * 128 + e] = hv[t];
    }
    __syncthreads();
    if (tid < 128) {
        const float g = ghm;
#pragma unroll
        for (int t = 0; t < 4; ++t) { const float s2 = sred[t] + sred[4 + t]; const float rstd = 1.0f / sqrtf(s2 * (1.0f / HDM) + EPS); const size_t go = (row0 + t) * DMW + hh * HDM + e;
            const float o = red[t * 128 + e] * rstd * g * omv[t]; ((bf16*)(F.ws + WS_YH))[(row0 + t) * D + DMW + hh * HDM + e] = (bf16)(pk2(o, 0.f) & 0xffffu); }
    }
    __syncthreads();
}
DI void conv_fixup_panel(Frame& F, int pm, int pn) {
    unsigned char* z = F.ws + WS_Z; const float* UB = (const float*)(z + Z_UB); bf16* ACT = (bf16*)(z + Z_ACT);
    const float* cw = inp(F, 23); const float* cb = inp(F, 24);
    const int tid = F.wave * 64 + lane_fresh();
    for (int c4 = tid; c4 < DFF / 4; c4 += NWAVES * 64) { const int ja = 4 * c4;
        f32x4 w0[2], w1[2], w2[2], bb[2], ur[2][4][4];
#pragma unroll
        for (int hb = 0; hb < 2; ++hb) { const int col = hb * DFF + ja;
            w0[hb] = *(const GAS f32x4*)(cw + col); w1[hb] = *(const GAS f32x4*)(cw + F2 + col); w2[hb] = *(const GAS f32x4*)(cw + 2 * F2 + col); bb[hb] = *(const GAS f32x4*)(cb + col);
#pragma unroll
            for (int sl = 0; sl < 4; ++sl) { const int sb = 4 * pm + sl; const bool first = (sb % (SEQ / 64)) == 0; const f32x4 zero = (f32x4){0.f, 0.f, 0.f, 0.f};
                ur[hb][sl][0] = first ? zero : *(const GAS f32x4*)(UB + ((size_t)(sb - 1) * 4 + 2) * F2 + col); ur[hb][sl][1] = first ? zero : *(const GAS f32x4*)(UB + ((size_t)(sb - 1) * 4 + 3) * F2 + col);
                ur[hb][sl][2] = *(const GAS f32x4*)(UB + ((size_t)sb * 4 + 0) * F2 + col); ur[hb][sl][3] = *(const GAS f32x4*)(UB + ((size_t)sb * 4 + 1) * F2 + col); } }
#pragma unroll
        for (int sl = 0; sl < 4; ++sl) { const int sb = 4 * pm + sl; f32x4 y0[2], y1[2];
#pragma unroll
            for (int hb = 0; hb < 2; ++hb) { y0[hb] = bb[hb] + w0[hb] * ur[hb][sl][0] + w1[hb] * ur[hb][sl][1] + w2[hb] * ur[hb][sl][2]; y1[hb] = bb[hb] + w0[hb] * ur[hb][sl][1] + w1[hb] * ur[hb][sl][2] + w2[hb] * ur[hb][sl][3]; }
            const f32x4 r0 = (f32x4){ep::gelu_t(y0[0][0]) * y0[1][0], ep::gelu_t(y0[0][1]) * y0[1][1], ep::gelu_t(y0[0][2]) * y0[1][2], ep::gelu_t(y0[0][3]) * y0[1][3]};
            const f32x4 r1 = (f32x4){ep::gelu_t(y1[0][0]) * y1[1][0], ep::gelu_t(y1[0][1]) * y1[1][1], ep::gelu_t(y1[0][2]) * y1[1][2], ep::gelu_t(y1[0][3]) * y1[1][3]};
            *(GAS u32x2*)(ACT + (size_t)(64 * sb) * DFF + ja) = ep::pk4(r0); *(GAS u32x2*)(ACT + (size_t)(64 * sb + 1) * DFF + ja) = ep::pk4(r1); }
    }
    if (pn == 0 && (pm & 7) == 7) { const int b = pm >> 3;
        f32x4 t_[6];
#pragma unroll
        for (int q = 0; q < 6; ++q) { const int it = tid + q * (NWAVES * 64); if (it < 2 * (F2 / 4)) t_[q] = *(const GAS f32x4*)(UB + ((size_t)(4 * pm + 3) * 4 + 2 + it / (F2 / 4)) * F2 + 4 * (it % (F2 / 4))); }
#pragma unroll
        for (int q = 0; q < 6; ++q) { const int it = tid + q * (NWAVES * 64); if (it < 2 * (F2 / 4)) *(GAS f32x4*)(F.out + O_CONVP + ((size_t)(b * 2 + it / (F2 / 4))) * F2 + 4 * (it % (F2 / 4))) = t_[q]; } }
    asm volatile("s_waitcnt vmcnt(0)" ::: "memory");
    __syncthreads();
}
template <int REPS> struct RepeatOrder { pg8::StaticOrder S;
    __device__ __forceinline__ bool next(int i, pg8::Unit& u) const { return S.next(i / REPS, u); }
    __device__ __forceinline__ void a_ready(const pg8::Unit&) const {}
    __device__ __forceinline__ void done(const pg8::Unit&) const {} };
struct ListOrder { int start, count;
    __device__ __forceinline__ bool next(int i, pg8::Unit& u) const { if (i >= count) return false; const int idx = start + i; u.pm = idx >> 2; u.pn = idx & 3; return true; }
    __device__ __forceinline__ void a_ready(const pg8::Unit&) const {}
    __device__ __forceinline__ void done(const pg8::Unit&) const {} };

constexpr int SM_LD = 36;
template <int NB> DI void sm_steps(const bf16* ap, const bf16* bp, int Kd, int kb, f32x4 (&acc)[4][2]) {
    v4u av[NB][4], bv[NB][2];
#pragma unroll
    for (int i = 0; i < NB; ++i) {
#pragma unroll
        for (int j = 0; j < 4; ++j) av[i][j] = *(const GAS v4u*)(ap + (size_t)(16 * j) * Kd + 32 * (kb + i));
#pragma unroll
        for (int n = 0; n < 2; ++n) bv[i][n] = *(const GAS v4u*)(bp + (size_t)(16 * n) * Kd + 32 * (kb + i)); }
#pragma unroll
    for (int i = 0; i < NB; ++i)
#pragma unroll
        for (int j = 0; j < 4; ++j)
#pragma unroll
            for (int n = 0; n < 2; ++n) acc[j][n] = __builtin_amdgcn_mfma_f32_16x16x32_bf16(__builtin_bit_cast(bf16x8, av[i][j]), __builtin_bit_cast(bf16x8, bv[i][n]), acc[j][n], 0, 0, 0);
}
template <int K, class Op, bool SPLIT = false> DI void small_tile(Frame& F, const bf16* A, const bf16* Bt, const Op& op) {
    const int lane = lane_fresh(), c = lane & 15, q = lane >> 4, w = F.wave, tid = w * 64 + lane;
    constexpr int NKS = K / 256, NB0 = (NKS > 6) ? (NKS + 1) / 2 : NKS, NB1 = NKS - NB0;
    static_assert(K % 256 == 0 && NB0 <= 6 && NB1 <= 6, "small tile: K per wave in 32-deep steps, at most two batches of six");
    const int kbeg = w * (K / 8);
#pragma unroll 1
    for (int tile = F.bid; tile < 256; tile += F.G) {
        const int row0 = MP + 64 * (tile >> 5), col0 = 32 * (tile & 31);
        const bf16* ap = A + (size_t)(row0 + c) * K + kbeg + 8 * q;
        const bf16* bp = Bt + (size_t)(col0 + c) * K + kbeg + 8 * q;
        f32x4 acc[4][2];
#pragma unroll
        for (int j = 0; j < 4; ++j)
#pragma unroll
            for (int n = 0; n < 2; ++n) acc[j][n] = (f32x4){0.f, 0.f, 0.f, 0.f};
        sm_steps<NB0>(ap, bp, K, 0, acc);
        if constexpr (NB1 > 0) sm_steps<NB1>(ap, bp, K, NB0, acc);
        const auto pre_ = op.load(row0 + (tid >> 3), col0 + (tid & 7) * 4);
        LAS float* red = (LAS float*)(F.lds + RING_OFF) + w * (64 * SM_LD);
#pragma unroll
        for (int j = 0; j < 4; ++j)
#pragma unroll
            for (int n = 0; n < 2; ++n)
#pragma unroll
                for (int e = 0; e < 4; ++e) red[(16 * j + 4 * q + e) * SM_LD + 16 * n + c] = acc[j][n][e];
        __syncthreads();
        { const int row = tid >> 3, c4 = (tid & 7) * 4; const LAS float* p = (const LAS float*)(F.lds + RING_OFF) + row * SM_LD + c4;
            f32x4 v = *(const LAS f32x4*)p, v2 = *(const LAS f32x4*)(p + 4 * 64 * SM_LD);
#pragma unroll
            for (int q = 1; q < 4; ++q) { v = v + *(const LAS f32x4*)(p + q * 64 * SM_LD); v2 = v2 + *(const LAS f32x4*)(p + (4 + q) * 64 * SM_LD); }
            if constexpr (SPLIT) op(row0 + row, col0 + c4, v, v2, pre_); else op(row0 + row, col0 + c4, v + v2, pre_); }
        __syncthreads();
    }
}
DI f32x4 up4(u32x2 g) { return (f32x4){lo16(g.x), hi16(g.x), lo16(g.y), hi16(g.y)}; }
DI u32x2 pk4v(f32x4 a) { return (u32x2){pk2(a[0], a[1]), pk2(a[2], a[3])}; }
struct SmMixK { const unsigned char* ga; const unsigned char* gm; bf16* out;
    struct Pre { unsigned a, b; };
    DI Pre load(int row, int col) const { const size_t off = (size_t)row * D + col; return Pre{*(const GAS unsigned*)(ga + off), *(const GAS unsigned*)(gm + off)}; }
    DI void operator()(int row, int col, f32x4 va, f32x4 vb, const Pre& p) const { const size_t off = (size_t)row * D + col; *(GAS u32x2*)(out + off) = pk4v(va * ep::dq8(p.a) + vb * ep::dq8(p.b)); } };
struct SmX1 { const float* irs; const float* gmix; bf16* xb; float* ss;
    struct Pre { f32x4 g; u32x2 x; float ir; };
    DI Pre load(int row, int col) const { return Pre{*(const GAS f32x4*)(gmix + col), *(const GAS u32x2*)(xb + (size_t)row * D + col), irs[row]}; }
    DI void operator()(int row, int col, f32x4 v, const Pre& p) const { const size_t off = (size_t)row * D + col; const f32x4 g = p.g;
        v = v + up4(p.x) * (f32x4){__builtin_amdgcn_rcpf(g[0]), __builtin_amdgcn_rcpf(g[1]), __builtin_amdgcn_rcpf(g[2]), __builtin_amdgcn_rcpf(g[3])} * p.ir; *(GAS u32x2*)(xb + off) = pk4v(v);
        float q = (v[0] * v[0] + v[1] * v[1]) + (v[2] * v[2] + v[3] * v[3]);
        q += __shfl_xor(q, 1); q += __shfl_xor(q, 2); q += __shfl_xor(q, 4);
        if ((col & 31) == 0) ss[(size_t)(row - MP) * 32 + (col >> 5)] = q; } };
template <bool DRY = false> struct SmX2 { bf16* xb;
    struct Pre { u32x2 x; };
    DI Pre load(int row, int col) const { return Pre{*(const GAS u32x2*)(xb + (size_t)row * D + col)}; }
    DI void operator()(int row, int col, f32x4 v, const Pre& p) const { const size_t off = (size_t)row * D + col; if (DRY) v = v * 0.f; v = v + up4(p.x);
        *(GAS u32x2*)(xb + off) = pk4v(v); } };
struct SmT { bf16* t;
    struct Pre { };
    DI Pre load(int, int) const { return Pre{}; }
    DI void operator()(int row, int col, f32x4 v, const Pre&) const { *(GAS u32x2*)(t + (size_t)row * D + col) = pk4v(v); } };
template <bool DRY = false> struct SmY { const bf16* xb; float* y; const bf16* t;
    struct Pre { u32x2 tw, x; };
    DI Pre load(int row, int col) const { const size_t off = (size_t)row * D + col; return Pre{*(const GAS u32x2*)(t + off), *(const GAS u32x2*)(xb + off)}; }
    DI void operator()(int row, int col, f32x4 v, const Pre& p) const { const size_t off = (size_t)row * D + col; const f32x4 tv = up4(p.tw);
        const float dz = DRY ? 0.f : 1.f; v = up4(p.x) + ep::sigm4(v) * tv * dz; __builtin_nontemporal_store(v, (GAS f32x4*)(y + off)); } };

#ifndef MK_N_LAUNCHES
#define MK_N_LAUNCHES 1
#endif
constexpr int PER_PHASE = 10;
constexpr int N_LAUNCHES = MK_N_LAUNCHES;
static_assert(N_LAUNCHES == 1 || N_LAUNCHES == PER_PHASE, "MK_N_LAUNCHES is 1 or 10");
#ifndef PG8_SP2
#define PG8_SP2 true
#endif
#ifndef PG8_ALIGN
#define PG8_ALIGN true
#endif
struct Args { const float* in[28]; float* out; unsigned char* ws; int ph_lo, ph_hi, li, pad; };
__global__ void __launch_bounds__(NWAVES * 64, 2) hybrid_fwd(Args args) {
    extern __shared__ __attribute__((aligned(16))) unsigned char lds[];
    Frame F;
    F.lds = (LAS unsigned char*)lds;
    F.MISC = (volatile LAS unsigned*)(F.lds + MISC_OFF);
    F.wave = __builtin_amdgcn_readfirstlane((int)threadIdx.x >> 6);
    F.G = gridDim.x; F.bid = blockIdx.x;
    F.out = args.out; F.ws = args.ws;
    F.ctl = (gu32*)(args.ws + WS_CTL);
    for (int u = threadIdx.x; u < (LDS_BYTES - LDSCTL_OFF) / 4; u += NWAVES * 64) ((LAS unsigned*)(F.lds + LDSCTL_OFF))[u] = 0u;
    __syncthreads();
    if (threadIdx.x < 28) ((LAS unsigned long long*)(F.lds + PTAB_OFF))[threadIdx.x] = (unsigned long long)args.in[threadIdx.x];
    __syncthreads();
    XcdBarrier bar; bar.wave = F.wave; bar.bar = (unsigned*)(F.ctl + CW_BAR); bar.x = 0; bar.st = nullptr;
    if (N_LAUNCHES == 1) bar = xcd_barrier_post((unsigned*)(F.ctl + CW_BAR), F.MISC + 8, F.wave);
#define GRID_BAR() do { if (N_LAUNCHES == 1) xcd_barrier(bar); } while (0)
    const int lo = args.ph_lo, hi = args.ph_hi;
#ifndef PHASE_MASK
#define PHASE_MASK 0x3ff
#endif
#define IN(k) ((((PHASE_MASK) >> (k)) & 1) && lo <= (k) && (k) < hi)
#define BOTH(k) (IN(k) && IN((k) + 1))
#ifndef PROBE_REPEAT
#define PROBE_REPEAT -1
#endif
constexpr int CW_SPLIT0 = 8192, CW_SPLIT1 = CW_SPLIT0 + 64 * 18;
#define CW_SPLITW(k) (CW_SPLIT0 + 64 * 18 * (k))
static_assert(CW_SPLITW(5) * 4 <= 65536 && CW_SPLIT0 >= CW_BAR + XCD_BAR_WORDS, "split-barrier words inside the memset, clear of the grid barrier's");
#ifndef STG_P6PRE
#define STG_P6PRE(cnt) ((cnt) > 0 ? 1 : 0)
#endif
#ifndef ML_UNIT
#define ML_UNIT(i) ((((i) & 7) << 5) + ((i) >> 3))
#endif
#ifndef STG_SMALL
#define STG_SMALL(b) ((((b) >> 3) & 1) ? 2 : 0)
#endif
#define REP(k) for (int rep_ = 0; rep_ < ((PROBE_REPEAT) == (k) ? 2 : 1); ++rep_, ({ asm volatile("" : "+s"(F.bid), "+s"(F.wave)); }))
    unsigned char* ws = args.ws; unsigned char* z = ws + WS_Z;
    bf16* BUFA = (bf16*)(ws + WS_BUFA);

    if (IN(0)) REP(0) { p0_prologue(F);
        if (N_LAUNCHES == 1 && BOTH(0)) split_arrive(bar, (unsigned*)(F.ctl + CW_SPLIT0));
        p0_weight_items(F, I_IN, NITEMS);
        if (N_LAUNCHES == 1 && BOTH(0)) split_wait(bar, (unsigned*)(F.ctl + CW_SPLIT0)); }

    if (IN(1)) REP(1) {
        pg8::Gemm g{BUFA, (const bf16*)(ws + WS_WIN), M, N1, D}; pg8::StaticOrder S; S.init(M, N1, F.G, F.bid);
        ep::EpiZ E{z};
#if PROBE_REPEAT == 11
        { RepeatOrder<2> S2{S}; pg8::gemm_phase<ep::EpiZ, RepeatOrder<2>, PG8_ALIGN, PG8_SP2>(F.lds + RING_OFF, g, S2, E, F.wave); }
#else
        pg8::gemm_phase<ep::EpiZ, pg8::StaticOrder, PG8_ALIGN, PG8_SP2>(F.lds + RING_OFF, g, S, E, F.wave);
#endif
        if (BOTH(1)) {
            if (N_LAUNCHES == 1) split_arrive(bar, (unsigned*)(F.ctl + CW_SPLITW(2)));
            { const int t_ = F.wave * 64 + lane_fresh(); if (t_ < 64) ((LAS float*)(F.lds + GQ_OFF))[t_] = inp(F, 14)[t_]; else if (t_ < 128) ((LAS float*)(F.lds + GQ_OFF))[t_] = inp(F, 15)[t_ - 64]; }
            if (F.bid < 256) mlstm_p1_pre(F, ML_UNIT(F.bid));
            if (N_LAUNCHES == 1) split_wait(bar, (unsigned*)(F.ctl + CW_SPLITW(2))); }
    }

    if (IN(2)) REP(2) {
        if (!BOTH(1)) { const int t_ = F.wave * 64 + lane_fresh(); if (t_ < 64) ((LAS float*)(F.lds + GQ_OFF))[t_] = inp(F, 14)[t_]; else if (t_ < 128) ((LAS float*)(F.lds + GQ_OFF))[t_] = inp(F, 15)[t_ - 64]; }
        __syncthreads();
#ifndef UNIT_MASK
#define UNIT_MASK 15
#endif
#ifndef PROBE_UNIT
#define PROBE_UNIT 15
#endif
        const int um_ = ((PROBE_REPEAT) == 2 && rep_ == 0) ? (PROBE_UNIT) : 15;
#pragma unroll 1
        for (int i = F.bid; i < 256; i += F.G) { if ((UNIT_MASK & 2) && (um_ & 2)) mlstm_p1_unit(F, ML_UNIT(i), BOTH(1) && i == F.bid); }
        if (N_LAUNCHES == 1 && BOTH(2)) split_arrive(bar, (unsigned*)(F.ctl + CW_SPLIT1));
#pragma unroll 1
        for (int i = F.bid; i < 256; i += F.G) { if ((UNIT_MASK & 1) && (um_ & 1)) attn_prompt_unit(F, ML_UNIT(i)); }
#pragma unroll 1
        for (int i = F.bid; i < 256; i += F.G) { if ((UNIT_MASK & 4) && (um_ & 4)) attn_sample_unit(F, i); }
        if ((UNIT_MASK & 8) && (um_ & 8)) { float ca[32], cb[32]; int i = F.bid;
            if (i < 512) mlstm_sample_c0(F, i, ca);
#pragma unroll 1
            for (; i < 512; i += 2 * F.G) { mlstm_sample_unit(F, i, ca, i + F.G, cb); if (i + F.G < 512) mlstm_sample_unit(F, i + F.G, cb, i + 2 * F.G, ca); } }
        if (N_LAUNCHES == 1 && BOTH(2)) { if (F.bid < 256) mlstm_p2_pre(F, ML_UNIT(F.bid));
            split_wait(bar, (unsigned*)(F.ctl + CW_SPLIT1)); }
    }

    if (IN(3)) REP(3) {
#pragma unroll 1
        for (int i = F.bid; i < 256; i += F.G) {
            mlstm_p2_unit(F, ML_UNIT(i), (N_LAUNCHES == 1 && BOTH(2)) && i == F.bid); }
        if (BOTH(3)) { if (N_LAUNCHES == 1) split_arrive(bar, (unsigned*)(F.ctl + CW_SPLITW(4))); }
    }

    if (IN(4)) REP(4) {
#pragma unroll 1
        for (int s_ = 0; s_ < 3; ++s_) {
          if (s_ == (BOTH(3) ? 0 : STG_SMALL(F.bid))) { SmMixK o{(const unsigned char*)(z + Z_GAU), (const unsigned char*)(z + Z_GMU), (bf16*)(z + Z_MIXED)}; small_tile<D, SmMixK, true>(F, (const bf16*)(ws + WS_YH), (const bf16*)(ws + WS_WOA), o);
            if (BOTH(3) && N_LAUNCHES == 1) split_wait(bar, (unsigned*)(F.ctl + CW_SPLITW(4))); }
          else if (s_ == 1) { pg8::Gemm g{(const bf16*)(ws + WS_YH), (const bf16*)(ws + WS_WOA), MP, D, D}; pg8::StaticOrder S; S.init(MP, D, F.G, F.bid);
            ep::EpiMixK E{(const unsigned char*)(z + Z_GAU), (const unsigned char*)(z + Z_GMU), (bf16*)(z + Z_MIXED)};
            pg8::gemm_phase<ep::EpiMixK, pg8::StaticOrder, PG8_ALIGN, PG8_SP2>(F.lds + RING_OFF, g, S, E, F.wave); } }
        if (BOTH(4)) GRID_BAR();
    }

    if (IN(5)) REP(5) {
#pragma unroll 1
        for (int s_ = 0; s_ < 3; ++s_) {
          if (s_ == STG_SMALL(F.bid)) { SmX1 o{(const float*)(ws + WS_RS), inp(F, 10), BUFA, (float*)(ws + WS_SSS)}; small_tile<D>(F, (const bf16*)(z + Z_MIXED), (const bf16*)(ws + WS_WOUT), o); }
          else if (s_ == 1) { pg8::Gemm g{(const bf16*)(z + Z_MIXED), (const bf16*)(ws + WS_WOUT), MP, D, D}; pg8::StaticOrder S; S.init(MP, D, F.G, F.bid);
            ep::EpiX1 E{(const float*)(ws + WS_RS), inp(F, 10), BUFA, (float*)(ws + WS_SS)};
            pg8::gemm_phase<ep::EpiX1, pg8::StaticOrder, PG8_ALIGN, PG8_SP2>(F.lds + RING_OFF, g, S, E, F.wave); } }
        if (BOTH(5) && N_LAUNCHES == 1) split_arrive(bar, (unsigned*)(F.ctl + CW_SPLITW(3)));
    }

    if (IN(6)) REP(6) {
        const int nwg_ = (M / 256) * (F2 / 256), rem_ = nwg_ % F.G, nidle_ = rem_ ? F.G - rem_ : F.G, j_ = rem_ ? F.bid - rem_ : F.bid;
        ListOrder L{0, 0};
        if (j_ >= 0) { const int q = 256 / nidle_, r = 256 % nidle_; L.start = j_ * q + (j_ < r ? j_ : r); L.count = q + (j_ < r ? 1 : 0); }
        const int pre_ = STG_P6PRE(L.count);
#pragma unroll 1
        for (int s_ = 0; s_ < 3; ++s_) {
          if (s_ == 1) {
            pg8::Gemm g{BUFA, (const bf16*)(ws + WS_WUP), M, F2, D}; pg8::StaticOrder S; S.init(M, F2, F.G, F.bid);
            ep::EpiConv E{(const float*)(ws + WS_SS), (const float*)(ws + WS_SSS), inp(F, 23), inp(F, 24), inp(F, 7), (bf16*)(z + Z_ACT), (float*)(z + Z_UB), F.out + O_CONVS, (LAS float*)(F.lds + PARAM_OFF)};
            pg8::gemm_phase<ep::EpiConv, pg8::StaticOrder, PG8_ALIGN, PG8_SP2>(F.lds + RING_OFF, g, S, E, F.wave);
          } else {
            if (s_ == 0) { SmT o{(bf16*)(z + Z_TPLE)}; small_tile<PLE>(F, (const bf16*)(ws + WS_PB), (const bf16*)(ws + WS_WPLE), o); }
            ListOrder L2{s_ == 0 ? L.start : L.start + pre_, s_ == 0 ? pre_ : L.count - pre_};
            pg8::Gemm g2{(const bf16*)(ws + WS_PB), (const bf16*)(ws + WS_WPLE), MP, D, PLE}; ep::EpiT E2{(bf16*)(z + Z_TPLE)};
            pg8::gemm_phase<ep::EpiT, ListOrder, PG8_ALIGN, PG8_SP2>(F.lds + RING_OFF, g2, L2, E2, F.wave);
            __syncthreads();
            if (s_ == 0 && BOTH(5) && N_LAUNCHES == 1) split_wait(bar, (unsigned*)(F.ctl + CW_SPLITW(3))); } }
        if (BOTH(6)) GRID_BAR();
    }

    if (IN(7)) REP(7) { }

    if (IN(8)) {
        { pg8::StaticOrder S0; S0.init(MP, D, F.G, F.bid); pg8::Unit u0; for (int i = 0; S0.next(i, u0); ++i) conv_fixup_panel(F, u0.pm, u0.pn); }
#if PROBE_REPEAT == 18
        { SmX2<true> o{BUFA}; small_tile<DFF>(F, (const bf16*)(z + Z_ACT), (const bf16*)(ws + WS_WDN), o); }
#endif
#if PROBE_REPEAT == 8
        { { SmX2<true> o{BUFA}; small_tile<DFF>(F, (const bf16*)(z + Z_ACT), (const bf16*)(ws + WS_WDN), o); }
          pg8::Gemm g{(const bf16*)(z + Z_ACT), (const bf16*)(ws + WS_WDN), MP, D, DFF}; pg8::StaticOrder S; S.init(MP, D, F.G, F.bid);
          ep::EpiX2<true> E{BUFA};
          pg8::gemm_phase<ep::EpiX2<true>, pg8::StaticOrder, PG8_ALIGN, PG8_SP2>(F.lds + RING_OFF, g, S, E, F.wave); GRID_BAR(); }
#endif
#pragma unroll 1
        for (int s_ = 0; s_ < 3; ++s_) {
          if (s_ == STG_SMALL(F.bid)) { SmX2<> o{BUFA}; small_tile<DFF>(F, (const bf16*)(z + Z_ACT), (const bf16*)(ws + WS_WDN), o); }
          else if (s_ == 1) { pg8::Gemm g{(const bf16*)(z + Z_ACT), (const bf16*)(ws + WS_WDN), MP, D, DFF}; pg8::StaticOrder S; S.init(MP, D, F.G, F.bid);
            ep::EpiX2<> E{BUFA};
            pg8::gemm_phase<ep::EpiX2<>, pg8::StaticOrder, PG8_ALIGN, PG8_SP2>(F.lds + RING_OFF, g, S, E, F.wave); } }
        if (BOTH(8)) GRID_BAR();
    }

    if (IN(9)) {
#if PROBE_REPEAT == 9
        { { SmY<true> o{BUFA, F.out + O_Y, (const bf16*)(z + Z_TPLE)}; small_tile<D>(F, BUFA, (const bf16*)(ws + WS_WG), o); }
          pg8::Gemm g{BUFA, (const bf16*)(ws + WS_WG), MP, D, D}; pg8::StaticOrder S; S.init(MP, D, F.G, F.bid);
          ep::EpiY<true> E{BUFA, F.out + O_Y, (const bf16*)(z + Z_TPLE)};
          pg8::gemm_phase<ep::EpiY<true>, pg8::StaticOrder, PG8_ALIGN, PG8_SP2>(F.lds + RING_OFF, g, S, E, F.wave); GRID_BAR(); }
#endif
#pragma unroll 1
        for (int s_ = 0; s_ < 3; ++s_) {
          if (s_ == STG_SMALL(F.bid)) { SmY<> o{BUFA, F.out + O_Y, (const bf16*)(z + Z_TPLE)}; small_tile<D>(F, BUFA, (const bf16*)(ws + WS_WG), o); }
          else if (s_ == 1) { pg8::Gemm g{BUFA, (const bf16*)(ws + WS_WG), MP, D, D}; pg8::StaticOrder S; S.init(MP, D, F.G, F.bid);
            ep::EpiY<> E{BUFA, F.out + O_Y, (const bf16*)(z + Z_TPLE)};
            pg8::gemm_phase<ep::EpiY<>, pg8::StaticOrder, PG8_ALIGN, PG8_SP2>(F.lds + RING_OFF, g, S, E, F.wave); } }
    }
#undef IN
#undef BOTH
#undef GRID_BAR
}

extern "C" void kernel_launch(void* const* d_in, const int* in_sizes, int n_in, void* d_out, int out_size, void* d_ws, size_t ws_size, hipStream_t stream) {
    static int grid = 0;
    if (grid == 0) {
        if (n_in != 28 || in_sizes[0] != MP * D || (size_t)out_size != O_END || ws_size < WS_TOTAL) {
            fprintf(stderr, "kernel_launch: built for 28 inputs, x_prompt of %d floats, out of %zu floats, >= %zu bytes of workspace; got n_in %d, in0 %d, out %d, ws %zu; nothing launched\n", MP * D, (size_t)O_END, (size_t)WS_TOTAL, n_in, n_in > 0 ? in_sizes[0] : -1, out_size, ws_size); grid = -1; return; }
        int dev = 0, cus = 0, per_cu = 0;
        if (hipGetDevice(&dev) != hipSuccess || hipDeviceGetAttribute(&cus, hipDeviceAttributeMultiprocessorCount, dev) != hipSuccess) { fprintf(stderr, "kernel_launch: device query failed\n"); grid = -1; return; }
        if (hipFuncSetAttribute((const void*)hybrid_fwd, hipFuncAttributeMaxDynamicSharedMemorySize, LDS_BYTES) != hipSuccess) { fprintf(stderr, "kernel_launch: hipFuncSetAttribute failed\n"); grid = -1; return; }
        if (hipOccupancyMaxActiveBlocksPerMultiprocessor(&per_cu, (const void*)hybrid_fwd, NWAVES * 64, LDS_BYTES) != hipSuccess || per_cu < 1) { fprintf(stderr, "kernel_launch: occupancy query reports %d workgroups per CU; nothing launched\n", per_cu); (void)hipGetLastError(); grid = -1; return; }
        (void)hipGetLastError();
        grid = cus;
    }
    if (grid < 0) return;
    static_assert((CW_BAR + XCD_BAR_WORDS) * 4 <= 65536, "control words inside the memset");
    if (hipMemsetAsync((char*)d_ws + WS_CTL, 0, 65536, stream) != hipSuccess)     { fprintf(stderr, "kernel_launch: hipMemsetAsync failed\n"); return; }
    Args a{};
    for (int i = 0; i < 28; ++i) a.in[i] = (const float*)d_in[i];
    a.out = (float*)d_out; a.ws = (unsigned char*)d_ws;
    for (int li = 0; li < N_LAUNCHES; ++li) {
        a.ph_lo = (N_LAUNCHES == PER_PHASE) ? li : 0; a.ph_hi = (N_LAUNCHES == PER_PHASE) ? li + 1 : PER_PHASE; a.li = li;
        hipLaunchKernelGGL(hybrid_fwd, dim3(grid), dim3(NWAVES * 64), LDS_BYTES, stream, a);
        const hipError_t le = hipPeekAtLastError();
        if (le != hipSuccess) { fprintf(stderr, "kernel_launch: launch %d failed: %s\n", li, hipGetErrorName(le)); break; }
    }
}
```

```cpp
#include <hip/hip_runtime.h>
#include <cstdio>
#include <cstdint>
#include <cmath>
namespace pg8 {
#define PG8_LAS __attribute__((address_space(3)))
typedef unsigned short bf16_t;
typedef short bf16x8 __attribute__((ext_vector_type(8)));
typedef float f32x4 __attribute__((ext_vector_type(4)));
typedef unsigned u32x4 __attribute__((ext_vector_type(4)));
constexpr int BM = 256, BK = 64, HALF = 128, HTB = HALF * BK * 2  , STAGE_BYTES = 8 * HTB, NXCD = 8, WGM = 8;

__host__ __device__ __forceinline__ int lds_byte(int r, int c) { const int st = (r >> 4) * 2 + (c >> 5), rr = r & 15, cc = c & 31, ob = rr * 64 + cc * 2; return st * 1024 + (ob ^ (((ob >> 9) & 1) << 5)); }
__host__ __device__ __forceinline__ void stage_rc(int b, int& R, int& C) { const int st = b / 1024, sb = b % 1024, swz = sb ^ (((sb >> 9) & 1) << 5); R = (st >> 1) * 16 + swz / 64; C = (st & 1) * 32 + (swz % 64) / 2; }
__host__ __device__ __forceinline__ int perm32(int rho) { const int n = rho >> 4, i = rho & 15; return 8 * (i >> 2) + 4 * n + (i & 3); }

struct Unit { int pm, pn; };
struct Gemm { const bf16_t* A; const bf16_t* Bt; int M, N, K; };

struct StaticOrder {
    int nM, nN, nwg, G, c;
    __host__ __device__ void init(int M, int N, int G_, int c_) { nM = M / BM; nN = N / BM; nwg = nM * nN; G = G_; c = c_; }
    __host__ __device__ bool next(int i, Unit& u) const {
        const long L = (long)i * G + c; if (L >= nwg) return false;
        int wgid = (int)L; { const int q = nwg / NXCD, r = nwg % NXCD, xcd = wgid % NXCD, off = wgid / NXCD; wgid = (xcd < r ? xcd * (q + 1) : r * (q + 1) + (xcd - r) * q) + off; }
        const int nig = WGM * nN, gid = wgid / nig, fm = gid * WGM, gsz = (nM - fm) < WGM ? (nM - fm) : WGM;
        u.pm = fm + ((wgid % nig) % gsz); u.pn = (wgid % nig) / gsz; return true;
    }
    __device__ __forceinline__ void a_ready(const Unit&) const {}
    __device__ __forceinline__ void done(const Unit&) const {}
};

template <class Epi, class Sched, bool ALIGN_EPI = false, bool SP2 = false>
__device__ __forceinline__ void gemm_phase(PG8_LAS unsigned char* lds, const Gemm g, const Sched& S, const Epi& E, const int wid) {
    unsigned z0_ = 0u; asm volatile("" : "+v"(z0_)); int lane_ = __builtin_amdgcn_mbcnt_hi(~0u, __builtin_amdgcn_mbcnt_lo(~0u, z0_)); asm volatile("" : "+v"(lane_));
    const int lane = lane_, tid = wid * 64 + lane, wr = wid >> 2, wc = wid & 3, fr = lane & 15, fq = lane >> 4;
    const int K = g.K, nt = K / BK;
    unsigned voffA[2], voffB[2];
#pragma unroll
    for (int i = 0; i < 2; ++i) { int R, C; stage_rc(tid * 16 + i * 8192, R, C); const int Rb = Epi::PERM ? ((R & ~31) + perm32(R & 31)) : R;
        const int Ra = Epi::PERMA ? ((R & 64) + 4 * (R & 15) + ((R >> 4) & 3)) : R;
        voffA[i] = (unsigned)(Ra * K + C) * 2u; voffB[i] = (unsigned)(Rb * K + C) * 2u; }
    const size_t kstep = (size_t)(BK * 2);
    const size_t hstep = (size_t)HALF * K * 2;
    const size_t tstep = 2 * hstep;
    const unsigned ldsw = (unsigned)wid * 1024u;
    const int aoff = lds_byte(wr * 64 + fr, fq * 8), boff = lds_byte(wc * 32 + fr, fq * 8);
#define PG8_SA(b, h) (((b) * 2 + (h)) * HTB)
#define PG8_SB(b, h) ((4 + (b) * 2 + (h)) * HTB)
#define PG8_STAGE(bufoff, gbase, voff) do { _Pragma("unroll") for (int _i = 0; _i < 2; ++_i) \
        __builtin_amdgcn_global_load_lds((const unsigned*)((const char*)(gbase) + (voff)[_i]), (PG8_LAS unsigned*)(lds + (bufoff) + ldsw + _i * 8192), 16, 0, 0); } while (0)
#define PG8_LDA(dst, b, h) do { _Pragma("unroll") for (int m = 0; m < 4; ++m) _Pragma("unroll") for (int k = 0; k < 2; ++k) dst[m][k] = *(const PG8_LAS bf16x8*)(lds + PG8_SA(b, h) + aoff + m * 2048 + k * 1024); } while (0)
#define PG8_LDB(dst, b, h) do { _Pragma("unroll") for (int n = 0; n < 2; ++n) _Pragma("unroll") for (int k = 0; k < 2; ++k) dst[n][k] = *(const PG8_LAS bf16x8*)(lds + PG8_SB(b, h) + boff + n * 2048 + k * 1024); } while (0)
#define PG8_MMA(ai, bj, At, Bt) do { __builtin_amdgcn_s_setprio(1); _Pragma("unroll") for (int m = 0; m < 4; ++m) _Pragma("unroll") for (int n = 0; n < 2; ++n) _Pragma("unroll") for (int k = 0; k < 2; ++k) \
        acc[ai][bj][m][n] = __builtin_amdgcn_mfma_f32_16x16x32_bf16(Bt[n][k], At[m][k], acc[ai][bj][m][n], 0, 0, 0); __builtin_amdgcn_s_setprio(0); } while (0)
#define PG8_WAIT_V(n) asm volatile("s_waitcnt vmcnt(" #n ")" ::: "memory")
#define PG8_WAIT_L(n) asm volatile("s_waitcnt lgkmcnt(" #n ")" ::: "memory")
#define PG8_BAR __builtin_amdgcn_s_barrier()
#define PG8_SCHED __builtin_amdgcn_sched_barrier(0)
    Unit cur, nxt; int ui = 0;
    if (!S.next(0, cur)) return;
    f32x4 acc[2][2][4][2];
#pragma unroll
    for (int a = 0; a < 2; ++a)
#pragma unroll
        for (int b = 0; b < 2; ++b)
#pragma unroll
            for (int m = 0; m < 4; ++m)
#pragma unroll
                for (int n = 0; n < 2; ++n) acc[a][b][m][n] = (f32x4){0.f, 0.f, 0.f, 0.f};
    bf16x8 At[4][2], B0[2][2], B1[2][2];
    const char* cA = (const char*)g.A + (size_t)cur.pm * tstep; const char* cB = (const char*)g.Bt + (size_t)cur.pn * tstep;
    S.a_ready(cur);
    if constexpr (SP2) {
        PG8_STAGE(PG8_SB(0, 0), cB, voffB); PG8_STAGE(PG8_SB(0, 1), cB + hstep, voffB); PG8_STAGE(PG8_SA(0, 0), cA, voffA); PG8_STAGE(PG8_SA(0, 1), cA + hstep, voffA);
        if (wr == 1) PG8_BAR;
        PG8_WAIT_V(2); PG8_BAR;
        PG8_STAGE(PG8_SB(1, 0), cB + kstep, voffB); PG8_STAGE(PG8_SA(1, 0), cA + kstep, voffA); PG8_STAGE(PG8_SB(1, 1), cB + hstep + kstep, voffB);
        PG8_WAIT_V(6); PG8_BAR;
    } else {
        PG8_STAGE(PG8_SB(0, 0), cB, voffB); PG8_STAGE(PG8_SA(0, 0), cA, voffA); PG8_STAGE(PG8_SB(0, 1), cB + hstep, voffB); PG8_STAGE(PG8_SA(0, 1), cA + hstep, voffA);
        if (wr == 1) PG8_BAR;
        PG8_WAIT_V(4); PG8_BAR;
        PG8_STAGE(PG8_SB(1, 0), cB + kstep, voffB); PG8_STAGE(PG8_SA(1, 0), cA + kstep, voffA); PG8_STAGE(PG8_SB(1, 1), cB + hstep + kstep, voffB);
        PG8_WAIT_V(6); PG8_BAR;
    }
    for (;;) {
        const bool has_next = S.next(ui + 1, nxt);
        const char* nA = has_next ? (const char*)g.A + (size_t)nxt.pm * tstep : cA; const char* nB = has_next ? (const char*)g.Bt + (size_t)nxt.pn * tstep : cB;
        for (int t = 0; t < nt; t += 2) {
            if constexpr (Epi::MIDT > 0) { if (t == Epi::MIDT) E.mid(acc, cur, wr, wc, fr, fq); }
            const bool last = (t == nt - 2);
            const char* a1 = cA + (size_t)(t + 1) * kstep;
            const char* a2 = last ? nA : cA + (size_t)(t + 2) * kstep; const char* b2 = last ? nB : cB + (size_t)(t + 2) * kstep;
            const char* a3 = a2 + kstep; const char* b3 = b2 + kstep;
            if (last && has_next) S.a_ready(nxt);
            if constexpr (SP2) {
            PG8_LDB(B0, 0, 0); PG8_LDB(B1, 0, 1); PG8_SCHED; PG8_LDA(At, 0, 0); PG8_STAGE(PG8_SA(1, 1), a1 + hstep, voffA);
            PG8_WAIT_V(8); PG8_WAIT_L(0); PG8_BAR; PG8_MMA(0, 0, At, B0); PG8_MMA(0, 1, At, B1); PG8_BAR; PG8_SCHED;
            PG8_LDA(At, 0, 1); PG8_STAGE(PG8_SB(0, 0), b2, voffB); PG8_STAGE(PG8_SB(0, 1), b2 + hstep, voffB); PG8_STAGE(PG8_SA(0, 0), a2, voffA);
            PG8_WAIT_V(8); PG8_WAIT_L(0); PG8_BAR; PG8_MMA(1, 0, At, B0); PG8_MMA(1, 1, At, B1); PG8_BAR; PG8_SCHED;
            PG8_LDB(B0, 1, 0); PG8_LDB(B1, 1, 1); PG8_SCHED; PG8_LDA(At, 1, 0); PG8_STAGE(PG8_SA(0, 1), a2 + hstep, voffA);
            PG8_WAIT_V(8); PG8_WAIT_L(0); PG8_BAR; PG8_MMA(0, 0, At, B0); PG8_MMA(0, 1, At, B1); PG8_BAR; PG8_SCHED;
            PG8_LDA(At, 1, 1); PG8_STAGE(PG8_SB(1, 0), b3, voffB); PG8_STAGE(PG8_SB(1, 1), b3 + hstep, voffB); PG8_STAGE(PG8_SA(1, 0), a3, voffA);
            PG8_WAIT_V(8); PG8_WAIT_L(0); PG8_BAR; PG8_MMA(1, 0, At, B0); PG8_MMA(1, 1, At, B1); PG8_BAR; PG8_SCHED;
            } else {
            PG8_LDB(B0, 0, 0); PG8_SCHED; PG8_LDA(At, 0, 0); PG8_STAGE(PG8_SA(1, 1), a1 + hstep, voffA);
            PG8_WAIT_L(8); PG8_BAR; PG8_WAIT_L(0); PG8_MMA(0, 0, At, B0); PG8_BAR; PG8_SCHED;
            PG8_LDB(B1, 0, 1); PG8_STAGE(PG8_SB(0, 0), b2, voffB);
            PG8_BAR; PG8_WAIT_L(0); PG8_MMA(0, 1, At, B1); PG8_BAR;
            PG8_LDA(At, 0, 1); PG8_STAGE(PG8_SA(0, 0), a2, voffA);
            PG8_BAR; PG8_WAIT_L(0); PG8_MMA(1, 0, At, B0); PG8_BAR; PG8_SCHED;
            PG8_STAGE(PG8_SB(0, 1), b2 + hstep, voffB);
            PG8_WAIT_V(6); PG8_BAR; PG8_MMA(1, 1, At, B1); PG8_BAR;
            PG8_LDB(B0, 1, 0); PG8_SCHED; PG8_LDA(At, 1, 0); PG8_STAGE(PG8_SA(0, 1), a2 + hstep, voffA);
            PG8_WAIT_L(8); PG8_BAR; PG8_WAIT_L(0); PG8_MMA(0, 0, At, B0); PG8_BAR; PG8_SCHED;
            PG8_LDB(B1, 1, 1); PG8_STAGE(PG8_SB(1, 0), b3, voffB);
            PG8_BAR; PG8_WAIT_L(0); PG8_MMA(0, 1, At, B1); PG8_BAR;
            PG8_LDA(At, 1, 1); PG8_STAGE(PG8_SA(1, 0), a3, voffA);
            PG8_BAR; PG8_WAIT_L(0); PG8_MMA(1, 0, At, B0); PG8_BAR; PG8_SCHED;
            PG8_STAGE(PG8_SB(1, 1), b3 + hstep, voffB);
            PG8_WAIT_V(6); PG8_BAR; PG8_MMA(1, 1, At, B1); PG8_BAR;
            }
        }
        if constexpr (ALIGN_EPI) { if (wr == 0) PG8_BAR; }
        if constexpr (!Epi::AFTER_DRAIN) { E(acc, cur, wr, wc, fr, fq); S.done(cur); }
        if (!has_next) break;
#pragma unroll
        for (int a = 0; a < 2; ++a)
#pragma unroll
            for (int b = 0; b < 2; ++b)
#pragma unroll
                for (int m = 0; m < 4; ++m)
#pragma unroll
                    for (int n = 0; n < 2; ++n) acc[a][b][m][n] = (f32x4){0.f, 0.f, 0.f, 0.f};
        cur = nxt; cA = nA; cB = nB; ++ui;
        if constexpr (ALIGN_EPI) { if (wr == 1) PG8_BAR; }
    }
    PG8_WAIT_V(0);
    if constexpr (!ALIGN_EPI) { if (wr == 0) PG8_BAR; }
    PG8_BAR;
    if constexpr (Epi::AFTER_DRAIN) { E.fused(acc, cur, wr, wc, fr, fq, lds, wid, lane); S.done(cur); }
#undef PG8_SA
#undef PG8_SB
#undef PG8_STAGE
#undef PG8_LDA
#undef PG8_LDB
#undef PG8_MMA
#undef PG8_WAIT_V
#undef PG8_WAIT_L
#undef PG8_BAR
#undef PG8_SCHED
}
}

constexpr int D = 1024, NBATCH = 8, SEQ = 2048, DBATCH = 128, DSEQ = 4;
constexpr int MP = NBATCH * SEQ, MS = DBATCH * DSEQ, M = MP + MS;
constexpr int QAW = 512, KVW = 128, HDA = 64, DMW = 512, HDM = 128, WIN = 128;
constexpr int DFF = 2816, F2 = 5632, PLE = 256, DIN = 4872;
constexpr int N1 = 4864;
constexpr float EPS = 1e-6f;
constexpr float LOG2E = 1.4426950408889634f;
constexpr size_t O_Y = 0, O_WKP = (size_t)M * D, O_WVP = O_WKP + 131072, O_CP = O_WVP + 131072, O_NP = O_CP + 524288, O_MP = O_NP + 4096, O_CONVP = O_MP + 32,
                 O_WKS = O_CONVP + 90112, O_WVS = O_WKS + 2097152, O_CS = O_WVS + 2097152, O_NS = O_CS + 8388608, O_MS = O_NS + 65536, O_CONVS = O_MS + 512, O_END = O_CONVS + 1441792;
static_assert(O_END == 32272928, "output size");
constexpr size_t WS_CTL = 0, CTL_ZERO_BYTES = 1u << 20;
constexpr size_t WS_WIN = CTL_ZERO_BYTES, WS_WOA = WS_WIN + (size_t)N1 * D * 2, WS_WOM = WS_WOA + (size_t)D * QAW * 2, WS_WOUT = WS_WOM + (size_t)D * DMW * 2, WS_WUP = WS_WOUT + (size_t)D * D * 2,
                 WS_WDN = WS_WUP + (size_t)F2 * D * 2, WS_WPLE = WS_WDN + (size_t)D * DFF * 2, WS_WG = WS_WPLE + (size_t)D * PLE * 2;
constexpr size_t WS_BUFA = WS_WG + (size_t)D * D * 2;
constexpr size_t WS_PB = WS_BUFA + (size_t)M * D * 2;
constexpr size_t WS_IG = WS_PB + (size_t)M * PLE * 2, WS_LF = WS_IG + (size_t)M * 16, WS_SS = WS_LF + (size_t)M * 16;
constexpr size_t WS_SSS = WS_SS + (size_t)M * 64;
constexpr size_t WS_RS = WS_SSS + (size_t)MS * 128;
constexpr size_t WS_Z = WS_RS + (size_t)M * 4;
constexpr size_t ZS512 = (size_t)M * 512 * 2, ZS128 = (size_t)M * 128 * 2, ZS1024 = (size_t)M * 1024 * 2;
constexpr size_t Z_QA = 0, Z_KA = Z_QA + ZS512, Z_VA = Z_KA + ZS128, Z_QM = Z_VA + ZS128, Z_KM = Z_QM + ZS512, Z_VM = Z_KM + ZS512, Z_OM = Z_VM + ZS512, Z_GA = Z_OM + ZS512, Z_GM = Z_GA + ZS1024, Z_END = Z_GM + ZS1024;
constexpr size_t WS_END = WS_Z + Z_END;
constexpr size_t Z_MIXED = Z_KM, Z_ACT = Z_QA, Z_TPLE = Z_GA, Z_UB = Z_GM;
constexpr size_t Z_GAU = Z_GA, Z_GMU = Z_GA + ZS512;
static_assert(Z_GA - Z_QA == (size_t)M * DFF * 2, "ACT overlay fits exactly");
static_assert((size_t)(MP / 64) * 4 * F2 * 4 <= ZS1024, "UB fits in GM");
constexpr size_t WS_YH = WS_Z + Z_GM;
constexpr size_t WS_MS = WS_END, MS_DC = 0, MS_DN = (size_t)256 * 16384 * 2, MS_DS = MS_DN + (size_t)256 * 128 * 4, WS_TOTAL = WS_MS + MS_DS + 4096;
static_assert(WS_TOTAL <= (size_t)256 << 20, "workspace");

namespace ep {
using pg8::f32x4; using pg8::u32x4; using pg8::bf16_t; using pg8::Unit; using pg8::BM; using pg8::HALF;
typedef unsigned u32x2 __attribute__((ext_vector_type(2)));
typedef float f32x2_t __attribute__((ext_vector_type(2))); typedef __bf16 bf16x2_t __attribute__((ext_vector_type(2)));
__device__ __forceinline__ unsigned pk2(float lo, float hi) { f32x2_t v = {lo, hi}; bf16x2_t b = __builtin_convertvector(v, bf16x2_t); return __builtin_bit_cast(unsigned, b); }
__device__ __forceinline__ float lo16(unsigned w) { return __uint_as_float(w << 16); }
__device__ __forceinline__ float hi16(unsigned w) { return __uint_as_float(w & 0xffff0000u); }
__device__ __forceinline__ f32x4 unpk4(u32x2 w) { return (f32x4){lo16(w.x), hi16(w.x), lo16(w.y), hi16(w.y)}; }
__device__ __forceinline__ u32x2 pk4(f32x4 v) { return (u32x2){pk2(v[0], v[1]), pk2(v[2], v[3])}; }
__device__ __forceinline__ float sigm(float x) { return __builtin_amdgcn_rcpf(1.0f + __builtin_amdgcn_exp2f(-LOG2E * x)); }
__device__ __forceinline__ f32x4 sigm4(f32x4 v) {
    const f32x4 a = v * (-LOG2E);
    const f32x4 d = (f32x4){__builtin_amdgcn_exp2f(a[0]), __builtin_amdgcn_exp2f(a[1]), __builtin_amdgcn_exp2f(a[2]), __builtin_amdgcn_exp2f(a[3])} + 1.0f;
    return (f32x4){__builtin_amdgcn_rcpf(d[0]), __builtin_amdgcn_rcpf(d[1]), __builtin_amdgcn_rcpf(d[2]), __builtin_amdgcn_rcpf(d[3])};
}
__device__ __forceinline__ float gelu_t(float x) { const float z2 = x * (1.0f + 0.044715f * x * x) * (2.0f * 0.7978845608028654f * LOG2E); return x * __builtin_amdgcn_rcpf(1.0f + __builtin_amdgcn_exp2f(-z2)); }

__device__ __forceinline__ float sum_fq(float q) {
    q += __builtin_bit_cast(float, __builtin_amdgcn_ds_swizzle(__builtin_bit_cast(int, q), 0x401F));
    float a = q, b = q;
    asm volatile("s_nop 1\n\tv_permlane32_swap_b32 %0, %1\n\ts_nop 1" : "+v"(a), "+v"(b));
    return a + b;
}
typedef float f32x2_t __attribute__((ext_vector_type(2)));
__device__ __forceinline__ f32x2_t gelu_t2(f32x2_t x) {
    constexpr float C0 = -2.0f * 0.7978845608028654f * LOG2E, C1 = C0 * 0.044715f;
    const f32x2_t a = x * (x * x * C1 + C0);
    const f32x2_t d = (f32x2_t){__builtin_amdgcn_exp2f(a[0]), __builtin_amdgcn_exp2f(a[1])} + 1.0f;
    return x * (f32x2_t){__builtin_amdgcn_rcpf(d[0]), __builtin_amdgcn_rcpf(d[1])};
}
__device__ __forceinline__ f32x4 gelu_t4(f32x4 x) { const f32x2_t lo = gelu_t2((f32x2_t){x[0], x[1]}), hi = gelu_t2((f32x2_t){x[2], x[3]}); return (f32x4){lo[0], lo[1], hi[0], hi[1]}; }
__device__ __forceinline__ float ror1(float x) { return __builtin_bit_cast(float, __builtin_amdgcn_update_dpp(0, __builtin_bit_cast(int, x), 0x121, 0xf, 0xf, false)); }
__device__ __forceinline__ float ror2(float x) { return __builtin_bit_cast(float, __builtin_amdgcn_update_dpp(0, __builtin_bit_cast(int, x), 0x122, 0xf, 0xf, false)); }
__device__ __forceinline__ float shr1(float x) { return __builtin_bit_cast(float, __builtin_amdgcn_update_dpp(0, __builtin_bit_cast(int, x), 0x111, 0xf, 0xf, true)); }
__device__ __forceinline__ f32x4 ror1v(f32x4 v) { return (f32x4){ror1(v[0]), ror1(v[1]), ror1(v[2]), ror1(v[3])}; }
__device__ __forceinline__ f32x4 ror2v(f32x4 v) { return (f32x4){ror2(v[0]), ror2(v[1]), ror2(v[2]), ror2(v[3])}; }
__device__ __forceinline__ unsigned q8(f32x4 v) { const f32x4 s = v * 255.0f + 0.5f; return (unsigned)s[0] | ((unsigned)s[1] << 8) | ((unsigned)s[2] << 16) | ((unsigned)s[3] << 24); }
__device__ __forceinline__ f32x4 dq8(unsigned w) { return (f32x4){(float)(w & 255u), (float)((w >> 8) & 255u), (float)((w >> 16) & 255u), (float)(w >> 24)} * (1.0f / 255.0f); }
struct EpiZ {
    static constexpr bool PERM = true, AFTER_DRAIN = false, PERMA = false; static constexpr int MIDT = 0;
    unsigned char* z;
    template <int OP> __device__ __forceinline__ void run(const f32x4 (&acc)[2][2][4][2], bf16_t* p0, bf16_t* p1, int ld, int row0, int cw) const {
#pragma unroll
        for (int ai = 0; ai < 2; ++ai)
#pragma unroll
            for (int m = 0; m < 4; ++m) { const unsigned ro = (unsigned)((row0 + ai * HALF + m * 16) * ld + cw) * 2u;
#pragma unroll
                for (int bj = 0; bj < 2; ++bj) { f32x4 v0 = acc[ai][bj][m][0], v1 = acc[ai][bj][m][1];
                    if (OP == 1) { v0 = v0 * 0.08838834764831845f; v1 = v1 * 0.08838834764831845f; }
                    if (OP >= 2) { v0 = sigm4(v0); v1 = sigm4(v1); }
                    if (OP == 3) { *(u32x2*)((unsigned char*)(bj ? p1 : p0) + (unsigned)((row0 + ai * HALF + m * 16) * 1024 + cw)) = (u32x2){q8(v0), q8(v1)}; }
                    else { u32x4 w; w.x = pk2(v0[0], v0[1]); w.y = pk2(v0[2], v0[3]); w.z = pk2(v1[0], v1[1]); w.w = pk2(v1[2], v1[3]); *(u32x4*)((unsigned char*)(bj ? p1 : p0) + ro) = w; } } }
    }
    __device__ __forceinline__ void operator()(const f32x4 (&acc)[2][2][4][2], const Unit& u, int wr, int wc, int fr, int fq) const {
        const int pn = u.pn; bf16_t* p0; bf16_t* p1; int ld; int op = 0;
        if (pn < 2)       { ld = 512; p0 = (bf16_t*)(z + Z_QA) + 256 * pn; p1 = p0 + 128; }
        else if (pn == 2) { ld = 128; p0 = (bf16_t*)(z + Z_KA); p1 = (bf16_t*)(z + Z_VA); }
        else if (pn < 11) { const int t = (pn - 3) >> 1, hs = (pn - 3) & 1; ld = 512; p0 = (bf16_t*)(z + Z_QM + (size_t)t * ZS512) + 256 * hs; p1 = p0 + 128; op = (t == 3) ? 2 : ((t == 1) ? 1 : 0); }
        else              { const int t = (pn - 11) >> 2, q = (pn - 11) & 3; ld = 1024; p0 = (bf16_t*)(z + Z_GAU + (size_t)t * ZS512) + 128 * q; p1 = p0 + 64; op = 3; }
        const int row0 = u.pm * BM + wr * 64 + fr, cw = wc * 32 + 8 * fq;
        if (op == 0) run<0>(acc, p0, p1, ld, row0, cw); else if (op == 1) run<1>(acc, p0, p1, ld, row0, cw); else if (op == 2) run<2>(acc, p0, p1, ld, row0, cw); else run<3>(acc, p0, p1, ld, row0, cw);
    }
};
struct EpiMixK {
    static constexpr bool PERM = true, AFTER_DRAIN = false, PERMA = false; static constexpr int MIDT = 8;
    const unsigned char* ga; const unsigned char* gm; bf16_t* out;
    __device__ __forceinline__ void mid(f32x4 (&acc)[2][2][4][2], const Unit& u, int wr, int wc, int fr_, int fq) const {
        int fr = fr_; asm volatile("" : "+v"(fr));
        const int row0 = u.pm * BM + wr * 64 + fr, col0 = u.pn * BM + wc * 32 + 8 * fq;
#pragma unroll
        for (int ai = 0; ai < 2; ++ai) {
            u32x2 a[4][2], b[4][2];
#pragma unroll
            for (int m = 0; m < 4; ++m)
#pragma unroll
                for (int bj = 0; bj < 2; ++bj) { const size_t off = (size_t)(row0 + ai * HALF + m * 16) * D + col0 + bj * HALF; a[m][bj] = *(const u32x2*)(ga + off); b[m][bj] = *(const u32x2*)(gm + off); }
#pragma unroll
            for (int m = 0; m < 4; ++m)
#pragma unroll
                for (int bj = 0; bj < 2; ++bj) { const f32x4 a0 = dq8(a[m][bj].x), a1 = dq8(a[m][bj].y), b0 = dq8(b[m][bj].x), b1 = dq8(b[m][bj].y);
                    const f32x4 r0 = (f32x4){a0[0] * __builtin_amdgcn_rcpf(fmaxf(b0[0], 1e-20f)), a0[1] * __builtin_amdgcn_rcpf(fmaxf(b0[1], 1e-20f)), a0[2] * __builtin_amdgcn_rcpf(fmaxf(b0[2], 1e-20f)), a0[3] * __builtin_amdgcn_rcpf(fmaxf(b0[3], 1e-20f))};
                    const f32x4 r1 = (f32x4){a1[0] * __builtin_amdgcn_rcpf(fmaxf(b1[0], 1e-20f)), a1[1] * __builtin_amdgcn_rcpf(fmaxf(b1[1], 1e-20f)), a1[2] * __builtin_amdgcn_rcpf(fmaxf(b1[2], 1e-20f)), a1[3] * __builtin_amdgcn_rcpf(fmaxf(b1[3], 1e-20f))};
                    acc[ai][bj][m][0] = acc[ai][bj][m][0] * r0; acc[ai][bj][m][1] = acc[ai][bj][m][1] * r1; }
        }
    }
    __device__ __forceinline__ void operator()(const f32x4 (&acc)[2][2][4][2], const Unit& u, int wr, int wc, int fr, int fq) const {
        const int row0 = u.pm * BM + wr * 64 + fr, col0 = u.pn * BM + wc * 32 + 8 * fq;
        u32x2 ball[2][4][2];
#pragma unroll
        for (int ai = 0; ai < 2; ++ai)
#pragma unroll
            for (int m = 0; m < 4; ++m)
#pragma unroll
                for (int bj = 0; bj < 2; ++bj) ball[ai][m][bj] = *(const u32x2*)(gm + (size_t)(row0 + ai * HALF + m * 16) * D + col0 + bj * HALF);
#pragma unroll
        for (int ai = 0; ai < 2; ++ai) {
            const u32x2 (&b)[4][2] = ball[ai];
#pragma unroll
            for (int m = 0; m < 4; ++m)
#pragma unroll
                for (int bj = 0; bj < 2; ++bj) { const size_t off = (size_t)(row0 + ai * HALF + m * 16) * D + col0 + bj * HALF; const f32x4 b0 = dq8(b[m][bj].x), b1 = dq8(b[m][bj].y);
                    const f32x4 v0 = acc[ai][bj][m][0] * (f32x4){fmaxf(b0[0], 1e-20f), fmaxf(b0[1], 1e-20f), fmaxf(b0[2], 1e-20f), fmaxf(b0[3], 1e-20f)};
                    const f32x4 v1 = acc[ai][bj][m][1] * (f32x4){fmaxf(b1[0], 1e-20f), fmaxf(b1[1], 1e-20f), fmaxf(b1[2], 1e-20f), fmaxf(b1[3], 1e-20f)};
                    u32x4 w; w.x = pk2(v0[0], v0[1]); w.y = pk2(v0[2], v0[3]); w.z = pk2(v1[0], v1[1]); w.w = pk2(v1[2], v1[3]);
                    *(u32x4*)(out + off) = w; }
        }
    }
};
struct EpiX1 {
    static constexpr bool PERM = true, AFTER_DRAIN = false, PERMA = false; static constexpr int MIDT = 0;
    const float* irs; const float* gmix; bf16_t* xb; float* ss;
    __device__ __forceinline__ void operator()(const f32x4 (&acc)[2][2][4][2], const Unit& u, int wr, int wc, int fr, int fq) const {
        const int row0 = u.pm * BM + wr * 64 + fr, col0 = u.pn * BM + wc * 32 + 8 * fq;
        f32x4 ig[2][2];
#pragma unroll
        for (int bj = 0; bj < 2; ++bj)
#pragma unroll
            for (int n = 0; n < 2; ++n) { const f32x4 g = *(const f32x4*)(gmix + col0 + bj * HALF + 4 * n); ig[bj][n] = (f32x4){__builtin_amdgcn_rcpf(g[0]), __builtin_amdgcn_rcpf(g[1]), __builtin_amdgcn_rcpf(g[2]), __builtin_amdgcn_rcpf(g[3])}; }
#pragma unroll
        for (int ai = 0; ai < 2; ++ai) {
            u32x4 r[4][2]; float rr[4];
#pragma unroll
            for (int m = 0; m < 4; ++m) { const int row = row0 + ai * HALF + m * 16; rr[m] = irs[row];
#pragma unroll
                for (int bj = 0; bj < 2; ++bj) r[m][bj] = *(const u32x4*)(xb + (size_t)row * D + col0 + bj * HALF); }
#pragma unroll
            for (int m = 0; m < 4; ++m) { const int row = row0 + ai * HALF + m * 16; float q = 0.f;
#pragma unroll
                for (int bj = 0; bj < 2; ++bj) { const u32x4 xw = r[m][bj];
                    const f32x4 v0 = (f32x4){lo16(xw.x), hi16(xw.x), lo16(xw.y), hi16(xw.y)} * ig[bj][0] * rr[m] + acc[ai][bj][m][0], v1 = (f32x4){lo16(xw.z), hi16(xw.z), lo16(xw.w), hi16(xw.w)} * ig[bj][1] * rr[m] + acc[ai][bj][m][1];
                    u32x4 w; w.x = pk2(v0[0], v0[1]); w.y = pk2(v0[2], v0[3]); w.z = pk2(v1[0], v1[1]); w.w = pk2(v1[2], v1[3]);
                    *(u32x4*)(xb + (size_t)row * D + col0 + bj * HALF) = w;
                    q += ((v0[0] * v0[0] + v0[1] * v0[1]) + (v0[2] * v0[2] + v0[3] * v0[3])) + ((v1[0] * v1[0] + v1[1] * v1[1]) + (v1[2] * v1[2] + v1[3] * v1[3])); }
                q += __shfl_xor(q, 16); q += __shfl_xor(q, 32);
                ss[(size_t)row * 16 + u.pn * 4 + wc] = q; }
        }
    }
};
template <bool DRY = false> struct EpiX2 {
    static constexpr bool PERM = true, AFTER_DRAIN = false, PERMA = false; static constexpr int MIDT = 0;
    bf16_t* xb;
    __device__ __forceinline__ void operator()(const f32x4 (&acc)[2][2][4][2], const Unit& u, int wr, int wc, int fr, int fq) const {
        const int row0 = u.pm * BM + wr * 64 + fr, col0 = u.pn * BM + wc * 32 + 8 * fq;
        u32x4 rall[2][4][2];
#pragma unroll
        for (int ai = 0; ai < 2; ++ai)
#pragma unroll
            for (int m = 0; m < 4; ++m)
#pragma unroll
                for (int bj = 0; bj < 2; ++bj) rall[ai][m][bj] = *(const u32x4*)(xb + (size_t)(row0 + ai * HALF + m * 16) * D + col0 + bj * HALF);
#pragma unroll
        for (int ai = 0; ai < 2; ++ai) {
            const u32x4 (&r)[4][2] = rall[ai];
#pragma unroll
            for (int m = 0; m < 4; ++m)
#pragma unroll
                for (int bj = 0; bj < 2; ++bj) { const size_t off = (size_t)(row0 + ai * HALF + m * 16) * D + col0 + bj * HALF; const u32x4 rr = r[m][bj];
                    const f32x4 v0 = (f32x4){lo16(rr.x), hi16(rr.x), lo16(rr.y), hi16(rr.y)} + (DRY ? acc[ai][bj][m][0] * 0.f : acc[ai][bj][m][0]);
                    const f32x4 v1 = (f32x4){lo16(rr.z), hi16(rr.z), lo16(rr.w), hi16(rr.w)} + (DRY ? acc[ai][bj][m][1] * 0.f : acc[ai][bj][m][1]);
                    u32x4 w; w.x = pk2(v0[0], v0[1]); w.y = pk2(v0[2], v0[3]); w.z = pk2(v1[0], v1[1]); w.w = pk2(v1[2], v1[3]);
                    *(u32x4*)(xb + off) = w; }
        }
    }
};
struct EpiT {
    static constexpr bool PERM = false, AFTER_DRAIN = false, PERMA = false; static constexpr int MIDT = 0;
    bf16_t* t;
    __device__ __forceinline__ void operator()(const f32x4 (&acc)[2][2][4][2], const Unit& u, int wr, int wc, int fr, int fq) const {
        const int row0 = u.pm * BM + wr * 64 + fr, col0 = u.pn * BM + wc * 32 + 4 * fq;
#pragma unroll
        for (int ai = 0; ai < 2; ++ai)
#pragma unroll
            for (int m = 0; m < 4; ++m)
#pragma unroll
                for (int bj = 0; bj < 2; ++bj)
#pragma unroll
                    for (int n = 0; n < 2; ++n) { const size_t off = (size_t)(row0 + ai * HALF + m * 16) * D + col0 + bj * HALF + n * 16; *(u32x2*)(t + off) = pk4(acc[ai][bj][m][n]); }
    }
};
template <bool DRY = false> struct EpiY {
    static constexpr bool PERM = true, AFTER_DRAIN = false, PERMA = false; static constexpr int MIDT = 0;
    const bf16_t* xb; float* y; const bf16_t* t;
    __device__ __forceinline__ void operator()(const f32x4 (&acc)[2][2][4][2], const Unit& u, int wr, int wc, int fr, int fq) const {
        const int row0 = u.pm * BM + wr * 64 + fr, col0 = u.pn * BM + wc * 32 + 8 * fq;
#pragma unroll
        for (int ai = 0; ai < 2; ++ai) {
            u32x4 r[4][2], tw[4][2];
#pragma unroll
            for (int m = 0; m < 4; ++m)
#pragma unroll
                for (int bj = 0; bj < 2; ++bj) { const size_t off = (size_t)(row0 + ai * HALF + m * 16) * D + col0 + bj * HALF; r[m][bj] = *(const u32x4*)(xb + off); tw[m][bj] = *(const u32x4*)(t + off); }
#pragma unroll
            for (int m = 0; m < 4; ++m)
#pragma unroll
                for (int bj = 0; bj < 2; ++bj) { const size_t off = (size_t)(row0 + ai * HALF + m * 16) * D + col0 + bj * HALF; const u32x4 rr = r[m][bj], tt = tw[m][bj];
                    f32x4 t0 = (f32x4){lo16(tt.x), hi16(tt.x), lo16(tt.y), hi16(tt.y)}, t1 = (f32x4){lo16(tt.z), hi16(tt.z), lo16(tt.w), hi16(tt.w)};
                    if (DRY) { t0 = t0 * 0.f; t1 = t1 * 0.f; }
                    __builtin_nontemporal_store((f32x4){lo16(rr.x), hi16(rr.x), lo16(rr.y), hi16(rr.y)} + sigm4(acc[ai][bj][m][0]) * t0, (f32x4*)(y + off));
                    __builtin_nontemporal_store((f32x4){lo16(rr.z), hi16(rr.z), lo16(rr.w), hi16(rr.w)} + sigm4(acc[ai][bj][m][1]) * t1, (f32x4*)(y + off + 4)); }
        }
    }
};
struct EpiConv {
    static constexpr bool PERM = true, AFTER_DRAIN = false, PERMA = true; static constexpr int MIDT = 0;
    const float* ss; const float* sss; const float* cw; const float* cb; const float* st; bf16_t* act; float* ub; float* cso; PG8_LAS float* pl;
    __device__ __forceinline__ void operator()(f32x4 (&acc)[2][2][4][2], const Unit& u, int wr, int wc, int fr_, int fq_) const {
        unsigned z_ = 0u; asm volatile("" : "+v"(z_)); int l_ = (int)__builtin_amdgcn_mbcnt_hi(~0u, __builtin_amdgcn_mbcnt_lo(~0u, z_)); asm volatile("" : "+v"(l_));
        const int fr = l_ & 15, fq = l_ >> 4; (void)fr_; (void)fq_;
        const bool sample = u.pm >= MP / BM;
        const int row0 = u.pm * BM + wr * 64 + 4 * fr;
        PG8_LAS float* P = pl + (wr * 4 + wc) * 256;
        const int pl_lane = fq * 16 + fr, pl_kind = pl_lane >> 4, pl_part = pl_lane & 15, pl_ucol = (pl_part < 8 ? 0 : DFF) + u.pn * 128 + wc * 32 + 4 * (pl_part & 7);
        const f32x4 pv4 = (pl_kind < 3) ? *(const f32x4*)(cw + pl_kind * F2 + pl_ucol) : *(const f32x4*)(cb + pl_ucol);
        *(PG8_LAS f32x4*)(P + pl_kind * 64 + pl_part * 4) = pv4;
        float rs[2][4];
        if (!sample) { f32x4 a[2][4];
#pragma unroll
            for (int ai = 0; ai < 2; ++ai)
#pragma unroll
                for (int m = 0; m < 4; ++m) a[ai][m] = *(const f32x4*)((const char*)ss + (unsigned)((row0 + ai * HALF + m) * 16 + 4 * fq) * 4u);
#pragma unroll
            for (int ai = 0; ai < 2; ++ai)
#pragma unroll
                for (int m = 0; m < 4; ++m) rs[ai][m] = (a[ai][m][0] + a[ai][m][1]) + (a[ai][m][2] + a[ai][m][3]);
        } else { f32x4 a[2][4], b2[2][4];
#pragma unroll
            for (int ai = 0; ai < 2; ++ai)
#pragma unroll
                for (int m = 0; m < 4; ++m) { const float* p_ = sss + (size_t)(row0 + ai * HALF + m - MP) * 32 + 8 * fq; a[ai][m] = *(const f32x4*)p_; b2[ai][m] = *(const f32x4*)(p_ + 4); }
#pragma unroll
            for (int ai = 0; ai < 2; ++ai)
#pragma unroll
                for (int m = 0; m < 4; ++m) rs[ai][m] = ((a[ai][m][0] + a[ai][m][1]) + (a[ai][m][2] + a[ai][m][3])) + ((b2[ai][m][0] + b2[ai][m][1]) + (b2[ai][m][2] + b2[ai][m][3]));
        }
#pragma unroll
        for (int ai = 0; ai < 2; ++ai)
#pragma unroll
            for (int m = 0; m < 4; ++m) { float q = rs[ai][m]; q += __shfl_xor(q, 16); q += __shfl_xor(q, 32); rs[ai][m] = __builtin_amdgcn_rsqf(q * (1.0f / D) + EPS); }
#pragma unroll
        for (int ai = 0; ai < 2; ++ai)
#pragma unroll
            for (int m = 0; m < 4; ++m)
#pragma unroll
                for (int bj = 0; bj < 2; ++bj) { acc[ai][bj][m][0] = acc[ai][bj][m][0] * rs[ai][m]; acc[ai][bj][m][1] = acc[ai][bj][m][1] * rs[ai][m]; }
#pragma unroll
        for (int n = 0; n < 2; ++n) {
            const int ja = u.pn * 128 + wc * 32 + 8 * fq + 4 * n;
#pragma unroll
            for (int hb = 1; hb >= 0; --hb) {
                const int uc = hb * DFF + ja;
                const PG8_LAS float* Pq = P + hb * 32 + 8 * fq + 4 * n;
                const f32x4 w0 = *(const PG8_LAS f32x4*)(Pq), w1 = *(const PG8_LAS f32x4*)(Pq + 64), w2 = *(const PG8_LAS f32x4*)(Pq + 128), bb = *(const PG8_LAS f32x4*)(Pq + 192);
                f32x4 h2[2], h3[2];
                if (sample) {
#pragma unroll
                    for (int ai = 0; ai < 2; ++ai) { const int sq = (row0 + ai * HALF - MP) >> 2; const float* sp = st + (size_t)(sq * 2) * F2 + uc; h2[ai] = *(const f32x4*)sp; h3[ai] = *(const f32x4*)(sp + F2); } }
#pragma unroll
                for (int ai = 0; ai < 2; ++ai) {
                    const int rowb = row0 + ai * HALF;
                    f32x4 uv[4];
#pragma unroll
                    for (int m = 0; m < 4; ++m) uv[m] = acc[ai][hb][m][n];
                    f32x4 p3, p2;
                    if (!sample) { p3 = (f32x4){shr1(uv[3][0]), shr1(uv[3][1]), shr1(uv[3][2]), shr1(uv[3][3])}; p2 = (f32x4){shr1(uv[2][0]), shr1(uv[2][1]), shr1(uv[2][2]), shr1(uv[2][3])};
                        if ((fr == 0) || (fr == 15)) { const bool e0 = fr == 0;
                            float* o = (float*)((char*)ub + (unsigned)(((rowb >> 6) * 4 + (e0 ? 0 : 2)) * F2 + uc) * 4u);
                            *(f32x4*)(o) = e0 ? uv[0] : uv[2]; *(f32x4*)(o + F2) = e0 ? uv[1] : uv[3]; }
                    } else { const int sq = (rowb - MP) >> 2;
                        p2 = h2[ai]; p3 = h3[ai];
                        __builtin_nontemporal_store(uv[2], (f32x4*)(cso + (size_t)(sq * 2 + 0) * F2 + uc)); __builtin_nontemporal_store(uv[3], (f32x4*)(cso + (size_t)(sq * 2 + 1) * F2 + uc)); }
                    f32x4 y[4];
                    y[0] = bb + w0 * p2 + w1 * p3 + w2 * uv[0];
                    y[1] = bb + w0 * p3 + w1 * uv[0] + w2 * uv[1];
                    y[2] = bb + w0 * uv[0] + w1 * uv[1] + w2 * uv[2];
                    y[3] = bb + w0 * uv[1] + w1 * uv[2] + w2 * uv[3];
#pragma unroll
                    for (int m = 0; m < 4; ++m) {
                        if (hb == 1) acc[ai][1][m][n] = y[m];
                        else { const f32x4 yb = acc[ai][1][m][n]; const f32x4 r = gelu_t4(y[m]) * yb;
                            *(u32x2*)((char*)act + (unsigned)((rowb + m) * DFF + ja) * 2u) = pk4(r); }
                    }
                }
            }
        }
    }
};
}
#define GAS __attribute__((address_space(1)))
#define LAS __attribute__((address_space(3)))
typedef unsigned short bf16;
typedef unsigned v4u __attribute__((ext_vector_type(4)));
typedef float f32x4 __attribute__((ext_vector_type(4)));
typedef short bf16x8 __attribute__((ext_vector_type(8)));
typedef GAS unsigned gu32;
typedef GAS unsigned long long gu64;
#define RLX_AGENT __ATOMIC_RELAXED, __HIP_MEMORY_SCOPE_AGENT
#define LDS_WAIT() asm volatile("s_waitcnt lgkmcnt(0)" ::: "memory")
#define VM_WAIT() asm volatile("s_waitcnt vmcnt(0)" ::: "memory")
__device__ __forceinline__ unsigned long long rt() { return __builtin_amdgcn_s_memrealtime(); }

#define XB_TMO      128
#define XB_XCNT(j)  (256  + 64 * (j))
#define XB_XSUB(j)  (1280 + 64 * (j))
#define XB_XGEN(j)  (2304 + 64 * (j))
#define XB_TOP      3328
#define XB_TOPGEN   3392
#define XCD_BAR_WORDS 3456
#define XB_SPIN_CAP (1u << 18)

__device__ __forceinline__ unsigned xb_ld(unsigned* p)              { return __hip_atomic_load(p, __ATOMIC_RELAXED, __HIP_MEMORY_SCOPE_AGENT); }
__device__ __forceinline__ unsigned xb_add(unsigned* p, unsigned v) { return __hip_atomic_fetch_add(p, v, __ATOMIC_RELAXED, __HIP_MEMORY_SCOPE_AGENT); }
__device__ __forceinline__ unsigned xb_xcc_id() { return (unsigned)__builtin_amdgcn_s_getreg((3 << 11) | 20) & 0xFu; }
#define XB_SPIN(cond, bar) do { unsigned _sp = 0; while (cond) { __builtin_amdgcn_s_sleep(1); \
    if ((++_sp & 255u) == 0u) { if (xb_ld(&(bar)[XB_TMO])) break; if (_sp > XB_SPIN_CAP) { atomicAdd(&(bar)[XB_TMO], 1u); break; } } } } while (0)

struct XcdBarrier {
    int wave; unsigned* bar; unsigned x;
    volatile LAS unsigned* st;
};

__device__ __forceinline__ bool xb_thread0(int wave) { unsigned z_ = 0u; asm volatile("" : "+v"(z_)); return wave == 0 && __builtin_amdgcn_mbcnt_hi(~0u, __builtin_amdgcn_mbcnt_lo(~0u, z_)) == 0; }
__device__ __forceinline__ XcdBarrier xcd_barrier_post(unsigned* bar, volatile LAS unsigned* st, int wave, unsigned lin_id) {
    XcdBarrier b; b.wave = wave; b.bar = bar; b.x = xb_xcc_id(); b.st = st;
    if (xb_thread0(wave)) (void)xb_add(&bar[XB_XCNT(b.x)], 1u + (((lin_id & 7u) != b.x) ? 0x10000u : 0u));
    return b;
}
__device__ __forceinline__ void xcd_barrier_complete(unsigned* bar, unsigned x, unsigned& nloc, unsigned& nx, unsigned& aligned) {
    const unsigned G = gridDim.x * gridDim.y * gridDim.z;
    unsigned sum, cnt, mine, bad, sp = 0u;
    for (;;) {
        sum = 0u; cnt = 0u; mine = 0u; bad = 0u;
#pragma unroll
        for (unsigned j = 0; j < 16; ++j) { const unsigned cw = xb_ld(&bar[XB_XCNT(j)]), c = cw & 0xffffu; sum += c; cnt += (c > 0u) ? 1u : 0u; mine = (j == x) ? c : mine;
            bad |= (cw >> 16) | ((c != 0u && (c != 32u || j >= 8u)) ? 1u : 0u); }
        if (sum == G) break;
        __builtin_amdgcn_s_sleep(1);
        if ((++sp & 255u) == 0u) { if (xb_ld(&bar[XB_TMO])) break; if (sp > XB_SPIN_CAP) { atomicAdd(&bar[XB_TMO], 1u); break; } }
    }
    nloc = mine > 0u ? mine : 1u; nx = cnt > 0u ? cnt : 1u;
    aligned = (sum == G && G == 256u && cnt == 8u && bad == 0u) ? 1u : 0u;
}

__device__ __forceinline__ void xcd_barrier(const XcdBarrier& b) {
    asm volatile("s_waitcnt vmcnt(0)" ::: "memory");
    __syncthreads();
    if (xb_thread0(b.wave)) {
        unsigned* bar = b.bar;
        __builtin_amdgcn_s_waitcnt(0);
        unsigned nloc = b.st[0], nx = b.st[1];
        if (nloc == 0u) { unsigned al_; xcd_barrier_complete(bar, b.x, nloc, nx, al_); b.st[0] = nloc; b.st[1] = nx; b.st[2] = al_; }
        const unsigned old = xb_add(&bar[XB_XSUB(b.x)], 1u);
        const unsigned gen = old / nloc;
        if (old + 1u == (gen + 1u) * nloc) {
            __builtin_amdgcn_fence(__ATOMIC_RELEASE, "agent");
            asm volatile("s_waitcnt vmcnt(0)" ::: "memory");
            const unsigned og = xb_add(&bar[XB_TOP], 1u);
            const unsigned tg = og / nx;
            if (og + 1u == (tg + 1u) * nx) xb_add(&bar[XB_TOPGEN], 1u);
            else XB_SPIN(xb_ld(&bar[XB_TOPGEN]) == tg, bar);
            __builtin_amdgcn_fence(__ATOMIC_ACQUIRE, "agent");
            xb_add(&bar[XB_XGEN(b.x)], 1u);
            asm volatile("s_waitcnt vmcnt(0)" ::: "memory");
        } else {
            XB_SPIN(xb_ld(&bar[XB_XGEN(b.x)]) == gen, bar);
            __builtin_amdgcn_fence(__ATOMIC_ACQUIRE, "agent");
            asm volatile("s_waitcnt vmcnt(0)" ::: "memory");
        }
    }
    __syncthreads();
}

__device__ __forceinline__ void split_arrive(const XcdBarrier& b, unsigned* w) {
    asm volatile("s_waitcnt vmcnt(0)" ::: "memory");
    __syncthreads();
    if (xb_thread0(b.wave)) {
        __builtin_amdgcn_s_waitcnt(0);
        unsigned nloc = b.st[0], nx = b.st[1];
        if (nloc == 0u) { unsigned al_; xcd_barrier_complete(b.bar, b.x, nloc, nx, al_); b.st[0] = nloc; b.st[1] = nx; b.st[2] = al_; }
        const unsigned old = xb_add(&w[64 * b.x], 1u);
        if (old + 1u == nloc) {
            __builtin_amdgcn_fence(__ATOMIC_RELEASE, "agent");
            asm volatile("s_waitcnt vmcnt(0)" ::: "memory");
            const unsigned og = xb_add(&w[64 * 16], 1u);
            if (og + 1u == nx) xb_add(&w[64 * 17], 1u);
        }
    }
}
__device__ __forceinline__ void split_wait(const XcdBarrier& b, unsigned* w) {
    if (xb_thread0(b.wave)) {
        XB_SPIN(xb_ld(&w[64 * 17]) == 0u, b.bar);
        __builtin_amdgcn_fence(__ATOMIC_ACQUIRE, "agent");
        asm volatile("s_waitcnt vmcnt(0)" ::: "memory");
    }
    __syncthreads();
}

__device__ __forceinline__ void xcc_barrier(const XcdBarrier& b, unsigned* w) {
    asm volatile("s_waitcnt vmcnt(0)" ::: "memory");
    __syncthreads();
    if (xb_thread0(b.wave)) {
        __builtin_amdgcn_s_waitcnt(0);
        const unsigned nloc = b.st[0];
        (void)xb_add(&w[64 * b.x], 1u);
        XB_SPIN(xb_ld(&w[64 * b.x]) < nloc, b.bar);
        __builtin_amdgcn_fence(__ATOMIC_ACQUIRE, "agent");
        asm volatile("s_waitcnt vmcnt(0)" ::: "memory");
    }
    __syncthreads();
}

constexpr int NWAVES = 8;
constexpr int RING_OFF = 0, RING_BYTES = 131072;
constexpr int LDSCTL_OFF = RING_BYTES, MISC_OFF = LDSCTL_OFF + 320;
constexpr int PTAB_OFF = LDSCTL_OFF + 512;
constexpr int PARAM_OFF = LDSCTL_OFF + 1024;
constexpr int LDS_BYTES = 147456;
constexpr int CW_TMO = 0, CW_BAR = 4096;
typedef short s16x4 __attribute__((ext_vector_type(4)));
typedef float f32x16 __attribute__((ext_vector_type(16)));
typedef unsigned u32x2 __attribute__((ext_vector_type(2)));
typedef short v4i16_t __attribute__((ext_vector_type(4)));
#define DI __device__ __forceinline__
using ep::pk2; using ep::lo16; using ep::hi16; using ep::sigm;

struct Frame {
    LAS unsigned char* lds;
    volatile LAS unsigned* MISC;
    gu32* ctl;
    int wave, G, bid;
    float* out; unsigned char* ws;
};
DI const float* inp(const Frame& F, int i) { const LAS unsigned* t = (const LAS unsigned*)(F.lds + PTAB_OFF) + 2 * i; const unsigned lo = __builtin_amdgcn_readfirstlane(t[0]), hi = __builtin_amdgcn_readfirstlane(t[1]);
    return (const float*)(const GAS float*)(((unsigned long long)hi << 32) | (unsigned long long)lo); }
DI int lane_fresh() { unsigned z_ = 0u; asm volatile("" : "+v"(z_)); int l = __builtin_amdgcn_mbcnt_hi(~0u, __builtin_amdgcn_mbcnt_lo(~0u, z_)); asm volatile("" : "+v"(l)); return l; }
DI float fexp(float x) { return __builtin_amdgcn_exp2f(x * LOG2E); }
DI float wave_sum(float v) {
#pragma unroll
    for (int o = 1; o < 64; o <<= 1) v += __shfl_xor(v, o);
    return v;
}
DI void unpack8(v4u w, float (&f)[8]) { f[0] = lo16(w.x); f[1] = hi16(w.x); f[2] = lo16(w.y); f[3] = hi16(w.y); f[4] = lo16(w.z); f[5] = hi16(w.z); f[6] = lo16(w.w); f[7] = hi16(w.w); }
DI v4u pack8(const float (&f)[8]) { v4u w; w.x = pk2(f[0], f[1]); w.y = pk2(f[2], f[3]); w.z = pk2(f[4], f[5]); w.w = pk2(f[6], f[7]); return w; }
DI f32x16 mfma32(bf16x8 a, bf16x8 b, f32x16 c) { return __builtin_amdgcn_mfma_f32_32x32x16_bf16(a, b, c, 0, 0, 0); }
DI s16x4 trd(const LAS bf16* p) { return __builtin_bit_cast(s16x4, __builtin_amdgcn_ds_read_tr16_b64_v4i16((LAS v4i16_t*)p)); }
DI int crow(int reg, int h) { return (reg & 3) + 8 * (reg >> 2) + 4 * h; }
DI bf16x8 cat8(s16x4 lo, s16x4 hi) { return __builtin_shufflevector(lo, hi, 0, 1, 2, 3, 4, 5, 6, 7); }
DI bf16x8 frag_t(const LAS bf16* X, int ld, int k0, int n0, int lane) {
    const int g = lane >> 4, q = (lane & 15) >> 2, p = lane & 3;
    const LAS bf16* a = X + (k0 + 8 * (g >> 1) + q) * ld + n0 + 16 * (g & 1) + 4 * p;
    return cat8(trd(a), trd(a + 4 * ld));
}
DI bf16x8 frag_tp(const LAS bf16* X, int ld, int k0, int n0, int lane) {
    const int g = lane >> 4, q = (lane & 15) >> 2, p = lane & 3;
    const LAS bf16* a = X + (k0 + 4 * (g >> 1) + q) * ld + n0 + 16 * (g & 1) + 4 * p;
    return cat8(trd(a), trd(a + 8 * ld));
}
DI bf16x8 packacc(const f32x16& x, int s) {
    v4u w; w.x = pk2(x[8 * s + 0], x[8 * s + 1]); w.y = pk2(x[8 * s + 2], x[8 * s + 3]); w.z = pk2(x[8 * s + 4], x[8 * s + 5]); w.w = pk2(x[8 * s + 6], x[8 * s + 7]);
    return __builtin_bit_cast(bf16x8, w);
}

template <bool SCALE> DI void p0_transpose_item(const float* W, int ldw, int src_col0, int K, bf16* WT, int dst_row0, int k0, const float* kscale, LAS float* scr, int lane) {
    float wv_[32];
#pragma unroll
    for (int i = 0; i < 32; ++i) wv_[i] = __builtin_nontemporal_load(W + (size_t)(k0 + 2 * i + (lane >> 5)) * ldw + src_col0 + (lane & 31));
    float ks_[32];
    if (SCALE) {
#pragma unroll
        for (int i = 0; i < 32; ++i) ks_[i] = kscale[k0 + 2 * i + (lane >> 5)]; }
#pragma unroll
    for (int i = 0; i < 32; ++i) { const int kk = 2 * i + (lane >> 5); float v = wv_[i]; if (SCALE) v *= ks_[i]; scr[kk * 33 + (lane & 31)] = v; }
    LDS_WAIT(); asm volatile("" ::: "memory");
    const int c = lane & 7;
#pragma unroll
    for (int j = 0; j < 4; ++j) { const int n = (lane >> 3) + 8 * j; const LAS float* s = scr + (8 * c) * 33 + n;
        v4u o; o.x = pk2(s[0 * 33], s[1 * 33]); o.y = pk2(s[2 * 33], s[3 * 33]); o.z = pk2(s[4 * 33], s[5 * 33]); o.w = pk2(s[6 * 33], s[7 * 33]);
        *(GAS v4u*)(WT + (size_t)(dst_row0 + n) * K + k0 + 8 * c) = o; }
    LDS_WAIT(); asm volatile("" ::: "memory");
}
constexpr int I_IN = 16 * (N1 / 32), I_OA = 8 * 32, I_OUT = 16 * 32, I_UP = 16 * (F2 / 32), I_DN = (DFF / 64) * 32, I_PLE = 4 * 32, I_G = 16 * 32;
constexpr int NITEMS = I_IN + 2 * I_OA + I_OUT + I_UP + I_DN + I_PLE + I_G;
DI void p0_weight_items(Frame& F, int it0, int it1, int gw_ = -1, int ngw_ = 0) {
    const int lane = lane_fresh();
    const int gw = gw_ >= 0 ? gw_ : F.bid * NWAVES + F.wave, NGW = gw_ >= 0 ? ngw_ : F.G * NWAVES;
    unsigned char* ws = F.ws;
    {
        LAS float* scr = (LAS float*)(F.lds + RING_OFF + F.wave * 8704);
        int it = (gw_ >= 0) ? it0 + gw : gw; if (gw_ < 0 && it < it0) it += ((it0 - it + NGW - 1) / NGW) * NGW;
        for (; it < it1; it += NGW) {
            int r = it; const float* W; int ldw, src, K, dst, k0; bf16* WT; bool scaled = false;
            if (r < I_IN) { const int nb = r % (N1 / 32), kb = r / (N1 / 32), n0 = nb * 32; W = inp(F, 11); ldw = DIN; src = n0 < 2816 ? n0 : n0 + 8; K = D; WT = (bf16*)(ws + WS_WIN); dst = n0; k0 = kb * 64; }
            else if ((r -= I_IN) < I_OA) { W = inp(F, 18); ldw = D; src = (r % 32) * 32; K = D; WT = (bf16*)(ws + WS_WOA); dst = src; k0 = (r / 32) * 64; }
            else if ((r -= I_OA) < I_OA) { W = inp(F, 19) - (size_t)QAW * D; ldw = D; src = (r % 32) * 32; K = D; WT = (bf16*)(ws + WS_WOA); dst = src; k0 = QAW + (r / 32) * 64; }
            else if ((r -= I_OA) < I_OUT) { W = inp(F, 20); ldw = D; src = (r % 32) * 32; K = D; WT = (bf16*)(ws + WS_WOUT); dst = src; k0 = (r / 32) * 64; }
            else if ((r -= I_OUT) < I_UP) { const int nb = r % (F2 / 32), kb = r / (F2 / 32), n0 = nb * 32, tile = n0 >> 8, within = n0 & 255;
                W = inp(F, 22); ldw = F2; src = within < 128 ? tile * 128 + within : DFF + tile * 128 + (within - 128); K = D; WT = (bf16*)(ws + WS_WUP); dst = n0; k0 = kb * 64; scaled = true; }
            else if ((r -= I_UP) < I_DN) { W = inp(F, 25); ldw = D; src = (r % 32) * 32; K = DFF; WT = (bf16*)(ws + WS_WDN); dst = src; k0 = (r / 32) * 64; }
            else if ((r -= I_DN) < I_PLE) { W = inp(F, 26); ldw = D; src = (r % 32) * 32; K = PLE; WT = (bf16*)(ws + WS_WPLE); dst = src; k0 = (r / 32) * 64; }
            else { r -= I_PLE; W = inp(F, 27); ldw = D; src = (r % 32) * 32; K = D; WT = (bf16*)(ws + WS_WG); dst = src; k0 = (r / 32) * 64; }
            if (scaled) p0_transpose_item<true>(W, ldw, src, K, WT, dst, k0, inp(F, 21), scr, lane); else p0_transpose_item<false>(W, ldw, src, K, WT, dst, k0, nullptr, scr, lane);
        }
    }
    __syncthreads();
}
DI void p0_prologue(Frame& F) {
    const int lane = lane_fresh(), tid = F.wave * 64 + lane;
    const int gw = F.bid * NWAVES + F.wave, NGW = F.G * NWAVES;
    unsigned char* ws = F.ws;
    p0_weight_items(F, 0, I_IN);
    LAS float* WGt = (LAS float*)(F.lds + RING_OFF);
    { const float* wi = inp(F, 11); float t_[16];
#pragma unroll
      for (int q = 0; q < 16; ++q) { const int i = tid + q * (NWAVES * 64); t_[q] = wi[(size_t)(i >> 3) * DIN + 2816 + (i & 7)]; }
#pragma unroll
      for (int q = 0; q < 16; ++q) { const int i = tid + q * (NWAVES * 64); WGt[(i & 7) * D + (i >> 3)] = t_[q]; } }
    __syncthreads();
    f32x4 g4[4];
#pragma unroll
    for (int j = 0; j < 4; ++j) g4[j] = ((const GAS f32x4*)inp(F, 10))[lane + 64 * j];
    bf16* XN = (bf16*)(ws + WS_BUFA); float* IG = (float*)(ws + WS_IG); float* LF = (float*)(ws + WS_LF); bf16* PB = (bf16*)(ws + WS_PB);
    const float* xP = inp(F, 0); const float* xS = inp(F, 1); const float* pP = inp(F, 8); const float* pS = inp(F, 9);
    const float b_i = inp(F, 12)[lane & 3], b_f = inp(F, 13)[lane & 3];
    f32x4 v[4], vn[4], vnn[4]; f32x4 pv, pvn, pvnn;
#define P0_LOAD(mm, vv, pp) do { if ((mm) < M) { const float* xrow = ((mm) < MP) ? xP + (size_t)(mm) * D : xS + (size_t)((mm) - MP) * D; const float* prow = ((mm) < MP) ? pP + (size_t)(mm) * PLE : pS + (size_t)((mm) - MP) * PLE; \
        _Pragma("unroll") for (int j = 0; j < 4; ++j) vv[j] = __builtin_nontemporal_load((const GAS f32x4*)xrow + lane + 64 * j); pp = __builtin_nontemporal_load((const GAS f32x4*)prow + lane); } } while (0)
    const bool g256_ = (F.G == 256); const int wloc_ = (F.bid >> 3) * NWAVES + F.wave, sidx_ = (F.wave & 3) ? (1 << 20) : F.bid * 2 + (F.wave >> 2);
#define P0_ROW(k) (g256_ ? ((k) < 8 ? 2048 * (F.bid & 7) + 256 * (k) + wloc_ : (((k) == 8 && sidx_ < M - MP) ? MP + sidx_ : M)) : ((gw + (k) * NGW < M) ? gw + (k) * NGW : M))
    { const int m0_ = P0_ROW(0), m1_ = P0_ROW(1); P0_LOAD(m0_, v, pv); P0_LOAD(m1_, vn, pvn); }
#pragma unroll 1
    for (int k_ = 0; ; ++k_) { const int m = P0_ROW(k_); if (m >= M) break;
        { const int m2_ = P0_ROW(k_ + 2); P0_LOAD(m2_, vnn, pvnn); }
        float s2 = 0.f;
#pragma unroll
        for (int j = 0; j < 4; ++j) s2 += (v[j].x * v[j].x + v[j].y * v[j].y) + (v[j].z * v[j].z + v[j].w * v[j].w);
        const float irs_ = sqrtf(wave_sum(s2) * (1.0f / D) + EPS), rstd = 1.0f / irs_;
        if (lane == 0) ((float*)(ws + WS_RS))[m] = irs_;
        float gd[8];
#pragma unroll
        for (int c = 0; c < 8; ++c) gd[c] = 0.f;
        GAS unsigned long long* o8 = (GAS unsigned long long*)(XN + (size_t)m * D) + lane;
#pragma unroll
        for (int j = 0; j < 4; ++j) { const f32x4 xn = v[j] * g4[j] * rstd;
            o8[64 * j] = (unsigned long long)pk2(xn.x, xn.y) | ((unsigned long long)pk2(xn.z, xn.w) << 32);
#pragma unroll
            for (int c = 0; c < 8; ++c) { const f32x4 w = *(const LAS f32x4*)(WGt + c * D + 4 * lane + 256 * j); gd[c] += (xn.x * w.x + xn.y * w.y) + (xn.z * w.z + xn.w * w.w); }
            asm volatile("" ::: "memory"); }
#pragma unroll
        for (int c = 0; c < 8; ++c) gd[c] = wave_sum(gd[c]);
        if (lane < 4) { float gi = gd[0], gf = gd[4];
            if (lane == 1) { gi = gd[1]; gf = gd[5]; } else if (lane == 2) { gi = gd[2]; gf = gd[6]; } else if (lane == 3) { gi = gd[3]; gf = gd[7]; }
            IG[(size_t)m * 4 + lane] = gi + b_i;
            const float xf = gf + b_f;
            LF[(size_t)m * 4 + lane] = fminf(xf, 0.f) - log1pf(expf(-fabsf(xf))); }
        ((GAS unsigned long long*)(PB + (size_t)m * PLE))[lane] = (unsigned long long)pk2(pv.x, pv.y) | ((unsigned long long)pk2(pv.z, pv.w) << 32);
#pragma unroll
        for (int j = 0; j < 4; ++j) { v[j] = vn[j]; vn[j] = vnn[j]; }
        pv = pvn; pvn = pvnn;
    }
#undef P0_LOAD
#undef P0_ROW
    __syncthreads();
}

constexpr int LDA = 72;
constexpr int LDM = 136;
constexpr int LDT = 160;
constexpr int LDV = 96;
constexpr int SC_OFF = 0, GQ_OFF = 5120, T0_OFF = 6144;

DI void attn_chunk(const LAS bf16* Ks, const LAS bf16* Vs, int kb0, const bf16x8 (&qf)[4], int qpos, int nlow, float slope2, float sink2, int lane, f32x16 (&ot)[2], float& inv) {
    const int r = lane & 31, h = lane >> 5;
    asm volatile("" : "+v"(slope2));
    const float base = slope2 * (float)(4 * h), sinkp = sink2 + slope2 * (float)(128 + qpos);
    f32x16 st[5];
#pragma unroll
    for (int kb = 0; kb < 5; ++kb) {
#pragma unroll
        for (int i = 0; i < 16; ++i) st[kb][i] = slope2 * (float)(32 * kb + (i & 3) + 8 * (i >> 2)) + base;
#pragma unroll
        for (int ks = 0; ks < 4; ++ks) { const bf16x8 a = *(const LAS bf16x8*)(Ks + (32 * (kb0 + kb) + r) * LDA + 16 * ks + 8 * h); st[kb] = mfma32(a, qf[ks], st[kb]); }
    }
    { float t_ = st[4][15]; asm volatile("" : "+v"(qpos), "+v"(t_)); st[4][15] = t_; }
#pragma unroll
    for (int i = 0; i < 16; ++i) { const int kk = crow(i, h); if (kk < qpos) st[0][i] = -INFINITY; if (kk > qpos) st[4][i] = -INFINITY; }
#pragma unroll
    for (int kb = 0; kb < 4; ++kb) if (kb < nlow) {
#pragma unroll
        for (int i = 0; i < 16; ++i) st[kb][i] = -INFINITY; }
    float mx = sinkp;
#pragma unroll
    for (int kb = 0; kb < 5; ++kb)
#pragma unroll
        for (int i = 0; i < 16; ++i) mx = fmaxf(mx, st[kb][i]);
    mx = fmaxf(mx, __shfl_xor(mx, 32));
    float sum = 0.f;
#pragma unroll
    for (int kb = 0; kb < 5; ++kb)
#pragma unroll
        for (int i = 0; i < 16; ++i) { const float e = __builtin_amdgcn_exp2f(st[kb][i] - mx); st[kb][i] = e; sum += e; }
    sum += __shfl_xor(sum, 32); sum += __builtin_amdgcn_exp2f(sinkp - mx);
    inv = 1.0f / sum;
#pragma unroll
    for (int db = 0; db < 2; ++db)
#pragma unroll
        for (int i = 0; i < 16; ++i) ot[db][i] = 0.f;
#pragma unroll
    for (int kb = 0; kb < 5; ++kb)
#pragma unroll
        for (int s = 0; s < 2; ++s) { const bf16x8 pf = packacc(st[kb], s);
#pragma unroll
            for (int db = 0; db < 2; ++db) { const bf16x8 vf = frag_tp(Vs, LDV, 32 * (kb0 + kb) + 16 * s, 32 * db, lane); ot[db] = mfma32(vf, pf, ot[db]); } }
}
DI void q_load(const bf16* qp, int lane, v4u (&qw)[4]) {
    const int h = lane >> 5;
#pragma unroll
    for (int ks = 0; ks < 4; ++ks) qw[ks] = *(const GAS v4u*)(qp + 16 * ks + 8 * h);
}
DI void q_norm(const v4u (&qw)[4], const LAS float* gq, int lane, bf16x8 (&qf)[4]) {
    const int h = lane >> 5; float f[4][8]; float s2 = 0.f;
#pragma unroll
    for (int ks = 0; ks < 4; ++ks) { unpack8(qw[ks], f[ks]);
#pragma unroll
        for (int j = 0; j < 8; ++j) s2 += f[ks][j] * f[ks][j]; }
    s2 += __shfl_xor(s2, 32);
    const float sc = (0.125f * LOG2E) / sqrtf(s2 * (1.0f / HDA) + EPS);
#pragma unroll
    for (int ks = 0; ks < 4; ++ks) { float o[8];
#pragma unroll
        for (int j = 0; j < 8; ++j) o[j] = f[ks][j] * sc * gq[16 * ks + 8 * h + j];
        qf[ks] = __builtin_bit_cast(bf16x8, pack8(o)); }
}
DI void attn_store(bf16* op, const f32x16 (&ot)[2], float inv, int h) {
#pragma unroll
    for (int db = 0; db < 2; ++db)
#pragma unroll
        for (int i4 = 0; i4 < 4; ++i4) { u32x2 w; w.x = pk2(ot[db][4 * i4] * inv, ot[db][4 * i4 + 1] * inv); w.y = pk2(ot[db][4 * i4 + 2] * inv, ot[db][4 * i4 + 3] * inv);
            *(GAS u32x2*)(op + 32 * db + 8 * i4 + 4 * h) = w; }
}
DI void attn_prompt_unit(Frame& F, int ui) {
    const int lane = lane_fresh(), tid = F.wave * 64 + lane;
    const int b = ui >> 5, jb = (ui >> 1) & 15, kvh = ui & 1;
    unsigned char* z = F.ws + WS_Z;
    const bf16* QA = (const bf16*)(z + Z_QA); const bf16* KA = (const bf16*)(z + Z_KA); const bf16* VA = (const bf16*)(z + Z_VA);
    LAS bf16* Ks = (LAS bf16*)(F.lds + T0_OFF); LAS bf16* Vs = Ks + 256 * LDA;
    const LAS float* gq = (const LAS float*)(F.lds + GQ_OFF); const LAS float* gk = gq + 64;
    v4u qw0[4], qw1[4];
    { const int r_ = lane & 31, p0 = F.wave * 2, p1 = p0 + 1;
      q_load(QA + (size_t)(b * SEQ + 128 * jb + 32 * (p0 & 3) + r_) * QAW + (kvh * 4 + (p0 >> 2)) * HDA, lane, qw0);
      q_load(QA + (size_t)(b * SEQ + 128 * jb + 32 * (p1 & 3) + r_) * QAW + (kvh * 4 + (p1 >> 2)) * HDA, lane, qw1); }
    v4u kws[4], vws[4];
#pragma unroll
    for (int i = 0; i < 4; ++i) { const int idx = tid + 512 * i, row = idx >> 3, ch = idx & 7, tok = 128 * (jb - 1) + row;
        kws[i] = (v4u){0u, 0u, 0u, 0u}; vws[i] = kws[i];
        if (tok >= 0) { const size_t go = (size_t)(b * SEQ + tok) * KVW + kvh * HDA + 8 * ch; kws[i] = *(const GAS v4u*)(KA + go); vws[i] = *(const GAS v4u*)(VA + go); } }
#pragma unroll
    for (int i = 0; i < 4; ++i) { const int idx = tid + 512 * i, row = idx >> 3, ch = idx & 7; const v4u kw = kws[i], vw = vws[i];
        float kf[8]; unpack8(kw, kf); float s2 = 0.f;
#pragma unroll
        for (int j = 0; j < 8; ++j) s2 += kf[j] * kf[j];
        s2 += __shfl_xor(s2, 1); s2 += __shfl_xor(s2, 2); s2 += __shfl_xor(s2, 4);
        const float rstd = 1.0f / sqrtf(s2 * (1.0f / HDA) + EPS);
#pragma unroll
        for (int j = 0; j < 8; ++j) kf[j] = kf[j] * rstd * gk[8 * ch + j];
        *(LAS v4u*)(Ks + row * LDA + 8 * ch) = pack8(kf); *(LAS v4u*)(Vs + row * LDV + 8 * ch) = vw;
        if (jb == 15 && row >= 128) { const size_t oo = ((size_t)(b * WIN + row - 128) * 2 + kvh) * HDA + 8 * ch; float vf[8]; unpack8(vw, vf);
            __builtin_nontemporal_store((f32x4){kf[0], kf[1], kf[2], kf[3]}, (GAS f32x4*)(F.out + O_WKP + oo)); __builtin_nontemporal_store((f32x4){kf[4], kf[5], kf[6], kf[7]}, (GAS f32x4*)(F.out + O_WKP + oo + 4));
            __builtin_nontemporal_store((f32x4){vf[0], vf[1], vf[2], vf[3]}, (GAS f32x4*)(F.out + O_WVP + oo)); __builtin_nontemporal_store((f32x4){vf[4], vf[5], vf[6], vf[7]}, (GAS f32x4*)(F.out + O_WVP + oo + 4)); }
    }
    __syncthreads();
    const int r = lane & 31, h = lane >> 5;
#pragma unroll 1
    for (int i = 0; i < 2; ++i) { const int pi = F.wave * 2 + i, g = pi >> 2, c = pi & 3, head = kvh * 4 + g;
        bf16x8 qf[4]; if (i == 0) q_norm(qw0, gq, lane, qf); else q_norm(qw1, gq, lane, qf);
        const float slope2 = exp2f(-(float)(head + 1)) * LOG2E, sink2 = inp(F, 16)[head] * LOG2E;
        f32x16 ot[2]; float inv;
        attn_chunk(Ks, Vs, c, qf, r, jb == 0 ? 4 - c : 0, slope2, sink2, lane, ot, inv);
        attn_store((bf16*)(F.ws + WS_YH) + (size_t)(b * SEQ + 128 * jb + 32 * c + r) * D + head * HDA, ot, inv, h);
    }
    __syncthreads();
}
DI void attn_sample_unit(Frame& F, int ui) {
    const int lane = lane_fresh(), tid = F.wave * 64 + lane;
    const int db = ui >> 1, kvh = ui & 1;
    unsigned char* z = F.ws + WS_Z;
    const bf16* QA = (const bf16*)(z + Z_QA); const bf16* KA = (const bf16*)(z + Z_KA); const bf16* VA = (const bf16*)(z + Z_VA);
    LAS bf16* Ks = (LAS bf16*)(F.lds + T0_OFF); LAS bf16* Vs = Ks + 256 * LDA;
    const LAS float* gq = (const LAS float*)(F.lds + GQ_OFF); const LAS float* gk = gq + 64;
    const float* ck = inp(F, 2); const float* cv = inp(F, 3);
    v4u qws[4]; { const int r_ = lane & 15; q_load(QA + (size_t)(MP + db * DSEQ + (r_ & 3)) * QAW + (kvh * 4 + (r_ >> 2)) * HDA, lane, qws); }
    v4u kwn = (v4u){0u, 0u, 0u, 0u}, vwn = kwn;
    if (tid < 32) { const size_t go = (size_t)(MP + db * DSEQ + (tid >> 3)) * KVW + kvh * HDA + 8 * (tid & 7); kwn = *(const GAS v4u*)(KA + go); vwn = *(const GAS v4u*)(VA + go); }
    f32x4 kvs[4], vvs[4];
#pragma unroll
    for (int i = 0; i < 4; ++i) { const int idx = tid + 512 * i, row = idx >> 4, c4 = idx & 15; const size_t so = ((size_t)(db * WIN + row) * 2 + kvh) * HDA + 4 * c4; kvs[i] = __builtin_nontemporal_load((const GAS f32x4*)(ck + so)); vvs[i] = __builtin_nontemporal_load((const GAS f32x4*)(cv + so)); }
#pragma unroll
    for (int i = 0; i < 4; ++i) { const int idx = tid + 512 * i, row = idx >> 4, c4 = idx & 15; const f32x4 kv = kvs[i], vv = vvs[i];
        *(LAS u32x2*)(Ks + row * LDA + 4 * c4) = (u32x2){pk2(kv.x, kv.y), pk2(kv.z, kv.w)}; *(LAS u32x2*)(Vs + row * LDV + 4 * c4) = (u32x2){pk2(vv.x, vv.y), pk2(vv.z, vv.w)};
        if (row >= DSEQ) { const size_t oo = ((size_t)(db * WIN + row - DSEQ) * 2 + kvh) * HDA + 4 * c4; __builtin_nontemporal_store(kv, (GAS f32x4*)(F.out + O_WKS + oo)); __builtin_nontemporal_store(vv, (GAS f32x4*)(F.out + O_WVS + oo)); } }
    if (tid < 32) { const int t = tid >> 3, ch = tid & 7;
        const v4u kw = kwn, vw = vwn;
        float kf[8]; unpack8(kw, kf); float s2 = 0.f;
#pragma unroll
        for (int j = 0; j < 8; ++j) s2 += kf[j] * kf[j];
        s2 += __shfl_xor(s2, 1); s2 += __shfl_xor(s2, 2); s2 += __shfl_xor(s2, 4);
        const float rstd = 1.0f / sqrtf(s2 * (1.0f / HDA) + EPS);
#pragma unroll
        for (int j = 0; j < 8; ++j) kf[j] = kf[j] * rstd * gk[8 * ch + j];
        *(LAS v4u*)(Ks + (WIN + t) * LDA + 8 * ch) = pack8(kf); *(LAS v4u*)(Vs + (WIN + t) * LDV + 8 * ch) = vw;
        const size_t oo = ((size_t)(db * WIN + WIN - DSEQ + t) * 2 + kvh) * HDA + 8 * ch; float vf[8]; unpack8(vw, vf);
        __builtin_nontemporal_store((f32x4){kf[0], kf[1], kf[2], kf[3]}, (GAS f32x4*)(F.out + O_WKS + oo)); __builtin_nontemporal_store((f32x4){kf[4], kf[5], kf[6], kf[7]}, (GAS f32x4*)(F.out + O_WKS + oo + 4));
        __builtin_nontemporal_store((f32x4){vf[0], vf[1], vf[2], vf[3]}, (GAS f32x4*)(F.out + O_WVS + oo)); __builtin_nontemporal_store((f32x4){vf[4], vf[5], vf[6], vf[7]}, (GAS f32x4*)(F.out + O_WVS + oo + 4));
    } else if (tid < 32 + 252) { const int c = tid - 32; const v4u zz = (v4u){0u, 0u, 0u, 0u};
        *(LAS v4u*)((LAS unsigned char*)(Ks + (WIN + DSEQ) * LDA) + 16 * c) = zz; *(LAS v4u*)((LAS unsigned char*)(Vs + (WIN + DSEQ) * LDV) + 16 * c) = zz; }
    __syncthreads();
    if (F.wave == 0) { const int r = lane & 15, g = r >> 2, t = r & 3, head = kvh * 4 + g, h = lane >> 5;
        bf16x8 qf[4]; q_norm(qws, gq, lane, qf);
        const float slope2 = exp2f(-(float)(head + 1)) * LOG2E, sink2 = inp(F, 16)[head] * LOG2E;
        f32x16 ot[2]; float inv;
        attn_chunk(Ks, Vs, 0, qf, t, 0, slope2, sink2, lane, ot, inv);
        if ((lane & 31) < 16) attn_store((bf16*)(F.ws + WS_YH) + (size_t)(MP + db * DSEQ + t) * D + head * HDA, ot, inv, h);
    }
    __syncthreads();
}
DI void mlstm_scalars(LAS float* sc, const float* LFp, const float* IGp, size_t row0, int hh, int tid) {
    LAS float* sF = sc; LAS float* sB = sc + 256; LAS float* sG = sc + 512; LAS float* red = sc + 1024;
    const int lane = tid & 63, wv = tid >> 6;
    float lf = 0.f, ig = 0.f; if (tid < 256) { lf = LFp[(row0 + tid) * 4 + hh]; ig = IGp[(row0 + tid) * 4 + hh]; }
    float Fv = lf;
#pragma unroll
    for (int o = 1; o < 64; o <<= 1) { const float t = __shfl_up(Fv, o); if (lane >= o) Fv += t; }
    if (tid < 256 && lane == 63) red[wv] = Fv;
    __syncthreads();
    if (wv < 4) for (int j = 0; j < wv; ++j) Fv += red[j];
    const float bv = ig - Fv; float Gv = bv;
#pragma unroll
    for (int o = 1; o < 64; o <<= 1) { const float t = __shfl_up(Gv, o); if (lane >= o) Gv = fmaxf(Gv, t); }
    if (tid < 256 && lane == 63) red[4 + wv] = Gv;
    __syncthreads();
    if (wv < 4) for (int j = 0; j < wv; ++j) Gv = fmaxf(Gv, red[4 + j]);
    if (tid < 256) { sF[tid] = Fv; sB[tid] = bv; sG[tid] = Gv; }
    __syncthreads();
}
DI void mlstm_p1_pre(Frame& F, int ui) {
    const int lane = lane_fresh(), tid = F.wave * 64 + lane;
    const int b = ui >> 5, hh = (ui >> 3) & 3, c = ui & 7;
    const size_t row0 = (size_t)b * SEQ + 256 * c;
    LAS float* sc = (LAS float*)(F.lds + SC_OFF); LAS float* sW = sc + 768;
    mlstm_scalars(sc, (const float*)(F.ws + WS_LF), (const float*)(F.ws + WS_IG), row0, hh, tid);
    const float g255 = sc[512 + 255], FL = sc[255];
    if (tid < 256) sW[tid] = fexp(sc[256 + tid] - g255);
    float* DS = (float*)(F.ws + WS_MS + MS_DS); if (tid == 0) { DS[ui * 2] = FL + g255; DS[ui * 2 + 1] = FL; }
    __syncthreads();
}
DI void mlstm_p1_unit(Frame& F, int ui, bool pre) {
    const int lane = lane_fresh(), tid = F.wave * 64 + lane;
    const int b = ui >> 5, hh = (ui >> 3) & 3, c = ui & 7, w = F.wave;
    const size_t row0 = (size_t)b * SEQ + 256 * c;
    unsigned char* z = F.ws + WS_Z; const bf16* KM = (const bf16*)(z + Z_KM); const bf16* VM = (const bf16*)(z + Z_VM);
    LAS float* sc = (LAS float*)(F.lds + SC_OFF); LAS float* sW = sc + 768;
    LAS bf16* Kc = (LAS bf16*)(F.lds + T0_OFF); LAS bf16* Vw = Kc + 128 * LDT;
    v4u kq[2][4], vq[2][4];
#pragma unroll
    for (int half = 0; half < 2; ++half)
#pragma unroll
        for (int i = 0; i < 4; ++i) { const int idx = tid + 512 * i, row = idx >> 4, ch = idx & 15, s = 128 * half + row; const size_t go = (row0 + s) * DMW + hh * HDM + 8 * ch;
            kq[half][i] = *(const GAS v4u*)(KM + go); vq[half][i] = *(const GAS v4u*)(VM + go); }
    if (!pre) {
    mlstm_scalars(sc, (const float*)(F.ws + WS_LF), (const float*)(F.ws + WS_IG), row0, hh, tid);
    const float g255 = sc[512 + 255], FL = sc[255];
    if (tid < 256) sW[tid] = fexp(sc[256 + tid] - g255);
    float* DS = (float*)(F.ws + WS_MS + MS_DS); if (tid == 0) { DS[ui * 2] = FL + g255; DS[ui * 2 + 1] = FL; }
    __syncthreads(); }
    f32x16 acc[2];
#pragma unroll
    for (int j = 0; j < 2; ++j)
#pragma unroll
        for (int i = 0; i < 16; ++i) acc[j][i] = 0.f;
    float dn = 0.f;
    const int dblk = w >> 1, eb0 = 2 * (w & 1);
#pragma unroll
    for (int half = 0; half < 2; ++half) {
#pragma unroll
        for (int i = 0; i < 4; ++i) { const int idx = tid + 512 * i, row = idx >> 4, ch = idx & 15, s = 128 * half + row;
            const v4u kw = kq[half][i], vw = vq[half][i]; float vf[8]; unpack8(vw, vf); const float ws_ = sW[s];
#pragma unroll
            for (int j = 0; j < 8; ++j) vf[j] *= ws_;
            *(LAS v4u*)(Kc + row * LDT + 8 * ch) = kw; *(LAS v4u*)(Vw + row * LDT + 8 * ch) = pack8(vf); }
        __syncthreads();
#pragma unroll
        for (int ks = 0; ks < 8; ++ks) { const bf16x8 a = frag_t(Kc, LDT, 16 * ks, 32 * dblk, lane);
#pragma unroll
            for (int j = 0; j < 2; ++j) { const bf16x8 bb = frag_t(Vw, LDT, 16 * ks, 32 * (eb0 + j), lane); acc[j] = mfma32(a, bb, acc[j]); } }
        { const int dcol = tid & 127, dq = tid >> 7;
#pragma unroll 8
          for (int s = 32 * dq; s < 32 * dq + 32; ++s) dn += sW[128 * half + s] * lo16((unsigned)Kc[s * LDT + dcol]); }
        __syncthreads();
    }
    bf16* DC = (bf16*)(F.ws + WS_MS + MS_DC) + (size_t)ui * 16384; float* DN = (float*)(F.ws + WS_MS + MS_DN) + (size_t)ui * 128;
    const int r = lane & 31, h = lane >> 5;
#pragma unroll
    for (int j = 0; j < 2; ++j)
#pragma unroll
        for (int i = 0; i < 16; ++i) Kc[(32 * dblk + crow(i, h)) * LDT + 32 * (eb0 + j) + r] = (bf16)(pk2(acc[j][i], 0.f) & 0xffffu);
    { LAS float* dnp = (LAS float*)Vw; dnp[tid] = dn; }
    __syncthreads();
    if (tid < 128) { const LAS float* dnp = (const LAS float*)Vw; DN[tid] = (dnp[tid] + dnp[tid + 128]) + (dnp[tid + 256] + dnp[tid + 384]); }
#pragma unroll
    for (int i = 0; i < 4; ++i) { const int idx = tid + 512 * i, d = idx >> 4, ch = idx & 15; *(GAS v4u*)(DC + d * 128 + 8 * ch) = *(const LAS v4u*)(Kc + d * LDT + 8 * ch); }
    __syncthreads();
}
DI void mlstm_rowfac(LAS float* sc, int tid) { if (tid < 256) sc[768 + tid] = fexp(sc[256 + tid] - sc[512 + (tid | 31)]); }
DI void mlstm_p2_pre(Frame& F, int ui) {
    const int lane = lane_fresh(), tid = F.wave * 64 + lane;
    const int b = ui >> 5, hh = (ui >> 3) & 3, c = ui & 7;
    const size_t row0 = (size_t)b * SEQ + 256 * c;
    unsigned char* z = F.ws + WS_Z; const bf16* KM = (const bf16*)(z + Z_KM); const bf16* VM = (const bf16*)(z + Z_VM);
    LAS float* sc = (LAS float*)(F.lds + SC_OFF);
    LAS bf16* Kc = (LAS bf16*)(F.lds + T0_OFF); LAS bf16* Vc = Kc + 128 * LDM;
    v4u kk[4], vv[4];
#pragma unroll
    for (int i = 0; i < 4; ++i) { const int idx = tid + 512 * i, row = idx >> 4, ch = idx & 15; const size_t go = (row0 + row) * DMW + hh * HDM + 8 * ch; kk[i] = *(const GAS v4u*)(KM + go); vv[i] = *(const GAS v4u*)(VM + go); }
    mlstm_scalars(sc, (const float*)(F.ws + WS_LF), (const float*)(F.ws + WS_IG), row0, hh, tid);
    mlstm_rowfac(sc, tid);
#pragma unroll
    for (int i = 0; i < 4; ++i) { const int idx = tid + 512 * i, row = idx >> 4, ch = idx & 15; *(LAS v4u*)(Kc + row * LDM + 8 * ch) = kk[i]; *(LAS v4u*)(Vc + row * LDT + 8 * ch) = vv[i]; }
    __syncthreads();
}
DI void mlstm_p2_unit(Frame& F, int ui, bool pre) {
    const int lane = lane_fresh(), tid = F.wave * 64 + lane;
    const int b = ui >> 5, hh = (ui >> 3) & 3, c = ui & 7, w = F.wave < 4 ? F.wave : 11 - F.wave;
    const size_t row0 = (size_t)b * SEQ + 256 * c;
    unsigned char* z = F.ws + WS_Z; const bf16* QM = (const bf16*)(z + Z_QM); const bf16* KM = (const bf16*)(z + Z_KM); const bf16* VM = (const bf16*)(z + Z_VM); const bf16* OM = (const bf16*)(z + Z_OM);
    LAS float* sc = (LAS float*)(F.lds + SC_OFF);
    LAS bf16* Kc = (LAS bf16*)(F.lds + T0_OFF); LAS bf16* Vc = Kc + 128 * LDM; LAS bf16* Cs = Vc + 128 * LDT; LAS float* ns = (LAS float*)(Cs + 128 * LDT);
    const float* DS = (const float*)(F.ws + WS_MS + MS_DS); const bf16* DCb = (const bf16*)(F.ws + WS_MS + MS_DC); const float* DNb = (const float*)(F.ws + WS_MS + MS_DN);
    const int u0 = ui - c;
    LAS float* gh = ns + 128;
    const int r = lane & 31, h = lane >> 5, t = 32 * w + r;
    const bf16* qp = QM + (row0 + t) * DMW + hh * HDM; bf16* hp = (bf16*)(F.ws + WS_YH) + (row0 + t) * D + DMW + hh * HDM;
    bf16x8 qf[8];
#pragma unroll
    for (int ks = 0; ks < 8; ++ks) qf[ks] = __builtin_bit_cast(bf16x8, *(const GAS v4u*)(qp + 16 * ks + 8 * h));
    const float ghv = inp(F, 17)[hh * HDM + (tid & 127)];
    v4u T[7][4]; float nT[7], Ms[7], FLs[7];
#pragma unroll
    for (int cp = 0; cp < 7; ++cp) { const int us = (cp < c) ? u0 + cp : ui;
#pragma unroll
        for (int i = 0; i < 4; ++i) T[cp][i] = *(const GAS v4u*)(DCb + (size_t)us * 16384 + 8 * (tid + 512 * i));
        nT[cp] = DNb[(size_t)us * 128 + (tid & 127)]; Ms[cp] = DS[us * 2]; FLs[cp] = DS[us * 2 + 1]; }
    if (!pre) { mlstm_scalars(sc, (const float*)(F.ws + WS_LF), (const float*)(F.ws + WS_IG), row0, hh, tid); mlstm_rowfac(sc, tid); }
    if (tid < 128) gh[tid] = ghv;
    v4u T7[4]; float nT7 = 0.f, Ms7 = 0.f, FLs7 = 0.f;
    if (c == 7) {
#pragma unroll
        for (int i = 0; i < 4; ++i) T7[i] = *(const GAS v4u*)(DCb + (size_t)ui * 16384 + 8 * (tid + 512 * i));
        nT7 = (tid < 128) ? DNb[(size_t)ui * 128 + tid] : 0.f; Ms7 = DS[ui * 2]; FLs7 = DS[ui * 2 + 1]; }
    float C[4][8]; float nv = 0.f; float mc = 0.f;
#pragma unroll
    for (int i = 0; i < 4; ++i)
#pragma unroll
        for (int j = 0; j < 8; ++j) C[i][j] = 0.f;
#pragma unroll
    for (int cp = 0; cp < 7; ++cp) if (cp < c) { const float mn = fmaxf(FLs[cp] + mc, Ms[cp]), dec = fexp(FLs[cp] + mc - mn), inj = fexp(Ms[cp] - mn);
#pragma unroll
        for (int i = 0; i < 4; ++i) { float f[8]; unpack8(T[cp][i], f);
#pragma unroll
            for (int j = 0; j < 8; ++j) C[i][j] = C[i][j] * dec + f[j] * inj; }
        nv = nv * dec + nT[cp] * inj; mc = mn; }
#pragma unroll
    for (int i = 0; i < 4; ++i) { const int idx = 8 * (tid + 512 * i), d = idx >> 7, e = idx & 127; *(LAS v4u*)(Cs + d * LDT + e) = pack8(C[i]); }
    if (tid < 128) ns[tid] = nv;
    if (c == 7) {
        const float mn = fmaxf(FLs7 + mc, Ms7), dec = fexp(FLs7 + mc - mn), inj = fexp(Ms7 - mn);
        float* dst = F.out + O_CP + (size_t)(b * 4 + hh) * 16384;
#pragma unroll
        for (int i = 0; i < 4; ++i) { float f[8]; unpack8(T7[i], f); const int idx = 8 * (tid + 512 * i);
            __builtin_nontemporal_store((f32x4){C[i][0] * dec + f[0] * inj, C[i][1] * dec + f[1] * inj, C[i][2] * dec + f[2] * inj, C[i][3] * dec + f[3] * inj}, (GAS f32x4*)(dst + idx));
            __builtin_nontemporal_store((f32x4){C[i][4] * dec + f[4] * inj, C[i][5] * dec + f[5] * inj, C[i][6] * dec + f[6] * inj, C[i][7] * dec + f[7] * inj}, (GAS f32x4*)(dst + idx + 4)); }
        if (tid < 128) F.out[O_NP + (size_t)(b * 4 + hh) * 128 + tid] = nv * dec + nT7 * inj;
        if (tid == 0) F.out[O_MP + b * 4 + hh] = mn;
    }
    __syncthreads();
    const float mu = fmaxf(mc, sc[512 + t]), at = fexp(mc - mu);
    f32x16 nt[4];
#pragma unroll
    for (int eb = 0; eb < 4; ++eb) {
#pragma unroll
        for (int i = 0; i < 16; ++i) nt[eb][i] = 0.f;
#pragma unroll
        for (int ks = 0; ks < 8; ++ks) { const bf16x8 a = frag_t(Cs, LDT, 16 * ks, 32 * eb, lane); nt[eb] = mfma32(a, qf[ks], nt[eb]); }
#pragma unroll
        for (int i = 0; i < 16; ++i) nt[eb][i] *= at;
    }
    float qn = 0.f;
#pragma unroll
    for (int ks = 0; ks < 8; ++ks) { float f[8]; unpack8(__builtin_bit_cast(v4u, qf[ks]), f);
#pragma unroll
        for (int j = 0; j < 8; ++j) qn += f[j] * ns[16 * ks + 8 * h + j]; }
    qn += __shfl_xor(qn, 32);
    float rowsum = 0.f;
#pragma unroll 1
    for (int half = 0; half < 2; ++half) {
        if (!(pre && half == 0)) {
#pragma unroll
        for (int i = 0; i < 4; ++i) { const int idx = tid + 512 * i, row = idx >> 4, ch = idx & 15, s = 128 * half + row; const size_t go = (row0 + s) * DMW + hh * HDM + 8 * ch;
            *(LAS v4u*)(Kc + row * LDM + 8 * ch) = *(const GAS v4u*)(KM + go); *(LAS v4u*)(Vc + row * LDT + 8 * ch) = *(const GAS v4u*)(VM + go); } }
        __syncthreads();
        if (w >= 4 * half) { const int nblk = (w - 4 * half + 1) < 4 ? (w - 4 * half + 1) : 4;
#pragma unroll 1
            for (int jb = 0; jb < nblk; ++jb) { const int sb = 4 * half + jb;
                const float cf = __builtin_amdgcn_exp2f((sc[512 + 32 * sb + 31] - mu) * LOG2E);
                f32x16 st;
#pragma unroll
                for (int i = 0; i < 16; ++i) st[i] = 0.f;
#pragma unroll
                for (int ks = 0; ks < 8; ++ks) { const bf16x8 a = *(const LAS bf16x8*)(Kc + (32 * jb + r) * LDM + 16 * ks + 8 * h); st = mfma32(a, qf[ks], st); }
                bf16x8 vfa[4], vfb[4];
#pragma unroll
                for (int eb = 0; eb < 4; ++eb) { vfa[eb] = frag_tp(Vc, LDT, 32 * jb, 32 * eb, lane); vfb[eb] = frag_tp(Vc, LDT, 32 * jb + 16, 32 * eb, lane); }
#pragma unroll
                for (int g4 = 0; g4 < 4; ++g4) { const f32x4 R4 = *(const LAS f32x4*)(sc + 768 + 32 * sb + 8 * g4 + 4 * h) * cf;
#pragma unroll
                    for (int e4 = 0; e4 < 4; ++e4) { const int i = 4 * g4 + e4, s = 32 * sb + crow(i, h); const float wv = (s <= t) ? st[i] * R4[e4] : 0.f; st[i] = wv; rowsum += wv; } }
                { const bf16x8 pf = packacc(st, 0);
#pragma unroll
                  for (int eb = 0; eb < 4; ++eb) nt[eb] = mfma32(vfa[eb], pf, nt[eb]); }
                { const bf16x8 pf = packacc(st, 1);
#pragma unroll
                  for (int eb = 0; eb < 4; ++eb) nt[eb] = mfma32(vfb[eb], pf, nt[eb]); }
            } }
        __syncthreads();
    }
    u32x2 omw[4][4];
    { const bf16* op = OM + (row0 + t) * DMW + hh * HDM;
#pragma unroll
      for (int eb = 0; eb < 4; ++eb)
#pragma unroll
          for (int i4 = 0; i4 < 4; ++i4) omw[eb][i4] = *(const GAS u32x2*)(op + 32 * eb + 8 * i4 + 4 * h); }
    rowsum += __shfl_xor(rowsum, 32);
    const float den = at * qn + rowsum, mt = sc[t] + mu, dnm = fmaxf(fabsf(den), fexp(-mt)), invd = 1.0f / dnm;
    float s2 = 0.f;
#pragma unroll
    for (int eb = 0; eb < 4; ++eb)
#pragma unroll
        for (int i = 0; i < 16; ++i) { nt[eb][i] *= invd; s2 += nt[eb][i] * nt[eb][i]; }
    s2 += __shfl_xor(s2, 32);
    const float rstd = 1.0f / sqrtf(s2 * (1.0f / HDM) + EPS);
#pragma unroll
    for (int eb = 0; eb < 4; ++eb)
#pragma unroll
        for (int i4 = 0; i4 < 4; ++i4) { const int e = 32 * eb + 8 * i4 + 4 * h; const f32x4 g = *(const LAS f32x4*)(gh + e); const u32x2 ow = omw[eb][i4];
            u32x2 o; o.x = pk2(nt[eb][4 * i4] * rstd * g.x * lo16(ow.x), nt[eb][4 * i4 + 1] * rstd * g.y * hi16(ow.x)); o.y = pk2(nt[eb][4 * i4 + 2] * rstd * g.z * lo16(ow.y), nt[eb][4 * i4 + 3] * rstd * g.w * hi16(ow.y));
            *(GAS u32x2*)(hp + e) = o; }
    __syncthreads();
}
DI void mlstm_sample_c0(Frame& F, int ui, float (&c0v)[32]) {
    const int tid = F.wave * 64 + lane_fresh(), e = tid & 127, qtr = tid >> 7; const float* C0 = inp(F, 4) + (size_t)ui * 16384;
#pragma unroll
    for (int dd = 0; dd < 32; ++dd) c0v[dd] = __builtin_nontemporal_load(C0 + (32 * qtr + dd) * 128 + e);
}
DI void mlstm_sample_unit(Frame& F, int ui, const float (&c0v)[32], int ui_next, float (&c0n)[32]) {
    const int lane = lane_fresh(), tid = F.wave * 64 + lane;
    const int db = ui >> 2, hh = ui & 3;
    const size_t row0 = (size_t)MP + db * DSEQ;
    unsigned char* z = F.ws + WS_Z; const bf16* QM = (const bf16*)(z + Z_QM); const bf16* KM = (const bf16*)(z + Z_KM); const bf16* VM = (const bf16*)(z + Z_VM); const bf16* OM = (const bf16*)(z + Z_OM);
    LAS float* sq = (LAS float*)(F.lds + T0_OFF); LAS float* sk = sq + 512; LAS float* sv = sk + 512; LAS float* sqk = sv + 512; LAS float* sqn = sqk + 16; LAS float* sred = sqn + 16; LAS float* red = sred + 16;
    const float* LFp = (const float*)(F.ws + WS_LF); const float* IGp = (const float*)(F.ws + WS_IG);
    const int e = tid & 127, qtr = tid >> 7;
    float* C1 = F.out + O_CS + (size_t)(db * 4 + hh) * 16384;
    { const int t = tid >> 7, dd = tid & 127; const size_t go = (row0 + t) * DMW + hh * HDM + dd; sq[tid] = lo16((unsigned)QM[go]); sk[tid] = lo16((unsigned)KM[go]); sv[tid] = lo16((unsigned)VM[go]); }
    float Fc[4], ig[4]; { float a = 0.f;
#pragma unroll
        for (int t = 0; t < 4; ++t) { a += LFp[(row0 + t) * 4 + hh]; Fc[t] = a; ig[t] = IGp[(row0 + t) * 4 + hh]; } }
    const float m0 = inp(F, 6)[db * 4 + hh]; const float* n0p = inp(F, 5) + (size_t)(db * 4 + hh) * 128;
    const float n0a = n0p[lane], n0b = n0p[64 + lane], n0t = n0p[tid & 127], ghm = inp(F, 17)[hh * HDM + (tid & 127)];
    float omv[4];
#pragma unroll
    for (int t = 0; t < 4; ++t) omv[t] = lo16((unsigned)OM[(row0 + t) * DMW + hh * HDM + (tid & 127)]);
    if (ui_next < 4 * DBATCH) mlstm_sample_c0(F, ui_next, c0n);
    __syncthreads();
    for (int j = F.wave; j < 20; j += NWAVES) {
        float a;
        if (j < 16) { const int t = j >> 2, s = j & 3; a = sq[t * 128 + lane] * sk[s * 128 + lane] + sq[t * 128 + 64 + lane] * sk[s * 128 + 64 + lane]; }
        else { const int t = j - 16; a = sq[t * 128 + lane] * n0a + sq[t * 128 + 64 + lane] * n0b; }
        a = wave_sum(a);
        if (lane == 0) { if (j < 16) sqk[j] = a; else sqn[j - 16] = a; } }
    float mt[4], ai[4];
#pragma unroll
    for (int t = 0; t < 4; ++t) { float mx = Fc[t] + m0;
#pragma unroll
        for (int s = 0; s < 4; ++s) if (s <= t) mx = fmaxf(mx, Fc[t] - Fc[s] + ig[s]);
        mt[t] = mx; ai[t] = fexp(Fc[t] + m0 - mx); }
    const float mnew = mt[3], dec = fexp(Fc[3] + m0 - mnew);
    float wsv[4];
#pragma unroll
    for (int s = 0; s < 4; ++s) wsv[s] = fexp(Fc[3] - Fc[s] + ig[s] - mnew);
    __syncthreads();
    float ve[4];
#pragma unroll
    for (int s = 0; s < 4; ++s) ve[s] = sv[s * 128 + e];
    float part[4] = {0.f, 0.f, 0.f, 0.f};
#pragma unroll
    for (int dd = 0; dd < 32; ++dd) { const int d = 32 * qtr + dd; const float c0 = c0v[dd]; float c1 = dec * c0;
#pragma unroll
        for (int s = 0; s < 4; ++s) { part[s] += sq[s * 128 + d] * c0; c1 += wsv[s] * sk[s * 128 + d] * ve[s]; }
        __builtin_nontemporal_store(c1, C1 + d * 128 + e); }
#pragma unroll
    for (int t = 0; t < 4; ++t) red[(qtr * 4 + t) * 128 + e] = part[t];
    __syncthreads();
    if (tid < 128) {
        float hv[4]; float s2p[4];
#pragma unroll
        for (int t = 0; t < 4; ++t) { const float inter = (red[(0 * 4 + t) * 128 + e] + red[(1 * 4 + t) * 128 + e]) + (red[(2 * 4 + t) * 128 + e] + red[(3 * 4 + t) * 128 + e]);
            float num = ai[t] * inter, den = ai[t] * sqn[t];
#pragma unroll
            for (int s = 0; s < 4; ++s) if (s <= t) { const float wts = sqk[t * 4 + s] * fexp(Fc[t] - Fc[s] + ig[s] - mt[t]); num += wts * ve[s]; den += wts; }
            hv[t] = num / fmaxf(fabsf(den), fexp(-mt[t])); s2p[t] = wave_sum(hv[t] * hv[t]); }
        if (lane == 0) {
#pragma unroll
            for (int t = 0; t < 4; ++t) sred[(tid >> 6) * 4 + t] = s2p[t]; }
        float n1 = dec * n0t;
#pragma unroll
        for (int s = 0; s < 4; ++s) n1 += wsv[s] * sk[s * 128 + tid];
        F.out[O_NS + (size_t)(db * 4 + hh) * 128 + tid] = n1;
        if (tid == 0) F.out[O_MS + db * 4 + hh] = mnew;
        asm volatile("s_waitcnt lgkmcnt(0)" ::: "memory");
#pragma unroll
        for (int t = 0; t < 4; ++t) red[t * 128 + e] = hv[t];
    }
    __syncthreads();
    if (tid < 128) {
        const float g = ghm;
#pragma unroll
        for (int t = 0; t < 4; ++t) { const float s2 = sred[t] + sred[4 + t]; const float rstd = 1.0f / sqrtf(s2 * (1.0f / HDM) + EPS); const size_t go = (row0 + t) * DMW + hh * HDM + e;
            const float o = red[t * 128 + e] * rstd * g * omv[t]; ((bf16*)(F.ws + WS_YH))[(row0 + t) * D + DMW + hh * HDM + e] = (bf16)(pk2(o, 0.f) & 0xffffu); }
    }
    __syncthreads();
}
DI void conv_fixup_panel(Frame& F, int pm, int pn) {
    unsigned char* z = F.ws + WS_Z; const float* UB = (const float*)(z + Z_UB); bf16* ACT = (bf16*)(z + Z_ACT);
    const float* cw = inp(F, 23); const float* cb = inp(F, 24);
    const int tid = F.wave * 64 + lane_fresh();
    for (int c4 = tid; c4 < DFF / 4; c4 += NWAVES * 64) { const int ja = 4 * c4;
        f32x4 w0[2], w1[2], w2[2], bb[2], ur[2][4][4];
#pragma unroll
        for (int hb = 0; hb < 2; ++hb) { const int col = hb * DFF + ja;
            w0[hb] = *(const GAS f32x4*)(cw + col); w1[hb] = *(const GAS f32x4*)(cw + F2 + col); w2[hb] = *(const GAS f32x4*)(cw + 2 * F2 + col); bb[hb] = *(const GAS f32x4*)(cb + col);
#pragma unroll
            for (int sl = 0; sl < 4; ++sl) { const int sb = 4 * pm + sl; const bool first = (sb % (SEQ / 64)) == 0; const f32x4 zero = (f32x4){0.f, 0.f, 0.f, 0.f};
                ur[hb][sl][0] = first ? zero : *(const GAS f32x4*)(UB + ((size_t)(sb - 1) * 4 + 2) * F2 + col); ur[hb][sl][1] = first ? zero : *(const GAS f32x4*)(UB + ((size_t)(sb - 1) * 4 + 3) * F2 + col);
                ur[hb][sl][2] = *(const GAS f32x4*)(UB + ((size_t)sb * 4 + 0) * F2 + col); ur[hb][sl][3] = *(const GAS f32x4*)(UB + ((size_t)sb * 4 + 1) * F2 + col); } }
#pragma unroll
        for (int sl = 0; sl < 4; ++sl) { const int sb = 4 * pm + sl; f32x4 y0[2], y1[2];
#pragma unroll
            for (int hb = 0; hb < 2; ++hb) { y0[hb] = bb[hb] + w0[hb] * ur[hb][sl][0] + w1[hb] * ur[hb][sl][1] + w2[hb] * ur[hb][sl][2]; y1[hb] = bb[hb] + w0[hb] * ur[hb][sl][1] + w1[hb] * ur[hb][sl][2] + w2[hb] * ur[hb][sl][3]; }
            const f32x4 r0 = (f32x4){ep::gelu_t(y0[0][0]) * y0[1][0], ep::gelu_t(y0[0][1]) * y0[1][1], ep::gelu_t(y0[0][2]) * y0[1][2], ep::gelu_t(y0[0][3]) * y0[1][3]};
            const f32x4 r1 = (f32x4){ep::gelu_t(y1[0][0]) * y1[1][0], ep::gelu_t(y1[0][1]) * y1[1][1], ep::gelu_t(y1[0][2]) * y1[1][2], ep::gelu_t(y1[0][3]) * y1[1][3]};
            *(GAS u32x2*)(ACT + (size_t)(64 * sb) * DFF + ja) = ep::pk4(r0); *(GAS u32x2*)(ACT + (size_t)(64 * sb + 1) * DFF + ja) = ep::pk4(r1); }
    }
    if (pn == 0 && (pm & 7) == 7) { const int b = pm >> 3;
        f32x4 t_[6];
#pragma unroll
        for (int q = 0; q < 6; ++q) { const int it = tid + q * (NWAVES * 64); if (it < 2 * (F2 / 4)) t_[q] = *(const GAS f32x4*)(UB + ((size_t)(4 * pm + 3) * 4 + 2 + it / (F2 / 4)) * F2 + 4 * (it % (F2 / 4))); }
#pragma unroll
        for (int q = 0; q < 6; ++q) { const int it = tid + q * (NWAVES * 64); if (it < 2 * (F2 / 4)) *(GAS f32x4*)(F.out + O_CONVP + ((size_t)(b * 2 + it / (F2 / 4))) * F2 + 4 * (it % (F2 / 4))) = t_[q]; } }
    asm volatile("s_waitcnt vmcnt(0)" ::: "memory");
    __syncthreads();
}
template <int REPS> struct RepeatOrder { pg8::StaticOrder S;
    __device__ __forceinline__ bool next(int i, pg8::Unit& u) const { return S.next(i / REPS, u); }
    __device__ __forceinline__ void a_ready(const pg8::Unit&) const {}
    __device__ __forceinline__ void done(const pg8::Unit&) const {} };
struct ListOrder { int start, count;
    __device__ __forceinline__ bool next(int i, pg8::Unit& u) const { if (i >= count) return false; const int idx = start + i; u.pm = idx >> 2; u.pn = idx & 3; return true; }
    __device__ __forceinline__ void a_ready(const pg8::Unit&) const {}
    __device__ __forceinline__ void done(const pg8::Unit&) const {} };

constexpr int SM_LD = 36;
template <int NB> DI void sm_steps(const bf16* ap, const bf16* bp, int Kd, int kb, f32x4 (&acc)[4][2]) {
    v4u av[NB][4], bv[NB][2];
#pragma unroll
    for (int i = 0; i < NB; ++i) {
#pragma unroll
        for (int j = 0; j < 4; ++j) av[i][j] = *(const GAS v4u*)(ap + (size_t)(16 * j) * Kd + 32 * (kb + i));
#pragma unroll
        for (int n = 0; n < 2; ++n) bv[i][n] = *(const GAS v4u*)(bp + (size_t)(16 * n) * Kd + 32 * (kb + i)); }
#pragma unroll
    for (int i = 0; i < NB; ++i)
#pragma unroll
        for (int j = 0; j < 4; ++j)
#pragma unroll
            for (int n = 0; n < 2; ++n) acc[j][n] = __builtin_amdgcn_mfma_f32_16x16x32_bf16(__builtin_bit_cast(bf16x8, av[i][j]), __builtin_bit_cast(bf16x8, bv[i][n]), acc[j][n], 0, 0, 0);
}
template <int K, class Op, bool SPLIT = false> DI void small_tile(Frame& F, const bf16* A, const bf16* Bt, const Op& op, int xr0 = -1, int xc0 = 0) {
    const int lane = lane_fresh(), c = lane & 15, q = lane >> 4, w = F.wave, tid = w * 64 + lane;
    constexpr int NKS = K / 256, NB0 = (NKS > 6) ? (NKS + 1) / 2 : NKS, NB1 = NKS - NB0;
    static_assert(K % 256 == 0 && NB0 <= 6 && NB1 <= 6, "small tile: K per wave in 32-deep steps, at most two batches of six");
    const int kbeg = w * (K / 8);
#pragma unroll 1
    for (int tile = (xr0 >= 0 ? 0 : F.bid); tile < (xr0 >= 0 ? 1 : 256); tile += F.G) {
        const int row0 = xr0 >= 0 ? xr0 : MP + 64 * (tile & 7), col0 = xr0 >= 0 ? xc0 : 32 * (tile >> 3);
        const bf16* ap = A + (size_t)(row0 + c) * K + kbeg + 8 * q;
        const bf16* bp = Bt + (size_t)(col0 + c) * K + kbeg + 8 * q;
        f32x4 acc[4][2];
#pragma unroll
        for (int j = 0; j < 4; ++j)
#pragma unroll
            for (int n = 0; n < 2; ++n) acc[j][n] = (f32x4){0.f, 0.f, 0.f, 0.f};
        sm_steps<NB0>(ap, bp, K, 0, acc);
        if constexpr (NB1 > 0) sm_steps<NB1>(ap, bp, K, NB0, acc);
        const auto pre_ = op.load(row0 + (tid >> 3), col0 + (tid & 7) * 4);
        LAS float* red = (LAS float*)(F.lds + RING_OFF) + w * (64 * SM_LD);
#pragma unroll
        for (int j = 0; j < 4; ++j)
#pragma unroll
            for (int n = 0; n < 2; ++n)
#pragma unroll
                for (int e = 0; e < 4; ++e) red[(16 * j + 4 * q + e) * SM_LD + 16 * n + c] = acc[j][n][e];
        __syncthreads();
        { const int row = tid >> 3, c4 = (tid & 7) * 4; const LAS float* p = (const LAS float*)(F.lds + RING_OFF) + row * SM_LD + c4;
            f32x4 v = *(const LAS f32x4*)p, v2 = *(const LAS f32x4*)(p + 4 * 64 * SM_LD);
#pragma unroll
            for (int q = 1; q < 4; ++q) { v = v + *(const LAS f32x4*)(p + q * 64 * SM_LD); v2 = v2 + *(const LAS f32x4*)(p + (4 + q) * 64 * SM_LD); }
            if constexpr (SPLIT) op(row0 + row, col0 + c4, v, v2, pre_); else op(row0 + row, col0 + c4, v + v2, pre_); }
        __syncthreads();
    }
}
DI f32x4 up4(u32x2 g) { return (f32x4){lo16(g.x), hi16(g.x), lo16(g.y), hi16(g.y)}; }
DI u32x2 pk4v(f32x4 a) { return (u32x2){pk2(a[0], a[1]), pk2(a[2], a[3])}; }
struct SmMixK { const unsigned char* ga; const unsigned char* gm; bf16* out;
    struct Pre { unsigned a, b; };
    DI Pre load(int row, int col) const { const size_t off = (size_t)row * D + col; return Pre{*(const GAS unsigned*)(ga + off), *(const GAS unsigned*)(gm + off)}; }
    DI void operator()(int row, int col, f32x4 va, f32x4 vb, const Pre& p) const { const size_t off = (size_t)row * D + col; *(GAS u32x2*)(out + off) = pk4v(va * ep::dq8(p.a) + vb * ep::dq8(p.b)); } };
struct SmX1 { const float* irs; const float* gmix; bf16* xb; float* ss;
    struct Pre { f32x4 g; u32x2 x; float ir; };
    DI Pre load(int row, int col) const { return Pre{*(const GAS f32x4*)(gmix + col), *(const GAS u32x2*)(xb + (size_t)row * D + col), irs[row]}; }
    DI void operator()(int row, int col, f32x4 v, const Pre& p) const { const size_t off = (size_t)row * D + col; const f32x4 g = p.g;
        v = v + up4(p.x) * (f32x4){__builtin_amdgcn_rcpf(g[0]), __builtin_amdgcn_rcpf(g[1]), __builtin_amdgcn_rcpf(g[2]), __builtin_amdgcn_rcpf(g[3])} * p.ir; *(GAS u32x2*)(xb + off) = pk4v(v);
        float q = (v[0] * v[0] + v[1] * v[1]) + (v[2] * v[2] + v[3] * v[3]);
        q += __shfl_xor(q, 1); q += __shfl_xor(q, 2); q += __shfl_xor(q, 4);
        if ((col & 31) == 0) ss[(size_t)(row - MP) * 32 + (col >> 5)] = q; } };
template <bool DRY = false> struct SmX2 { bf16* xb;
    struct Pre { u32x2 x; };
    DI Pre load(int row, int col) const { return Pre{*(const GAS u32x2*)(xb + (size_t)row * D + col)}; }
    DI void operator()(int row, int col, f32x4 v, const Pre& p) const { const size_t off = (size_t)row * D + col; if (DRY) v = v * 0.f; v = v + up4(p.x);
        *(GAS u32x2*)(xb + off) = pk4v(v); } };
struct SmT { bf16* t;
    struct Pre { };
    DI Pre load(int, int) const { return Pre{}; }
    DI void operator()(int row, int col, f32x4 v, const Pre&) const { *(GAS u32x2*)(t + (size_t)row * D + col) = pk4v(v); } };
template <bool DRY = false> struct SmY { const bf16* xb; float* y; const bf16* t;
    struct Pre { u32x2 tw, x; };
    DI Pre load(int row, int col) const { const size_t off = (size_t)row * D + col; return Pre{*(const GAS u32x2*)(t + off), *(const GAS u32x2*)(xb + off)}; }
    DI void operator()(int row, int col, f32x4 v, const Pre& p) const { const size_t off = (size_t)row * D + col; const f32x4 tv = up4(p.tw);
        const float dz = DRY ? 0.f : 1.f; v = up4(p.x) + ep::sigm4(v) * tv * dz; __builtin_nontemporal_store(v, (GAS f32x4*)(y + off)); } };

#ifndef MK_N_LAUNCHES
#define MK_N_LAUNCHES 1
#endif
constexpr int PER_PHASE = 10;
constexpr int N_LAUNCHES = MK_N_LAUNCHES;
static_assert(N_LAUNCHES == 1 || N_LAUNCHES == PER_PHASE, "MK_N_LAUNCHES is 1 or 10");
#ifndef PG8_SP2
#define PG8_SP2 true
#endif
#ifndef PG8_ALIGN
#define PG8_ALIGN true
#endif
struct Args { const float* in[28]; float* out; unsigned char* ws; int ph_lo, ph_hi, li, pad; };
__global__ void __launch_bounds__(NWAVES * 64, 2) hybrid_fwd(Args args) {
    extern __shared__ __attribute__((aligned(16))) unsigned char lds[];
    Frame F;
    F.lds = (LAS unsigned char*)lds;
    F.MISC = (volatile LAS unsigned*)(F.lds + MISC_OFF);
    F.wave = __builtin_amdgcn_readfirstlane((int)threadIdx.x >> 6);
    F.G = gridDim.x; F.bid = blockIdx.x;
    F.out = args.out; F.ws = args.ws;
    F.ctl = (gu32*)(args.ws + WS_CTL);
    for (int u = threadIdx.x; u < (LDS_BYTES - LDSCTL_OFF) / 4; u += NWAVES * 64) ((LAS unsigned*)(F.lds + LDSCTL_OFF))[u] = 0u;
    __syncthreads();
    if (threadIdx.x < 28) ((LAS unsigned long long*)(F.lds + PTAB_OFF))[threadIdx.x] = (unsigned long long)args.in[threadIdx.x];
    __syncthreads();
    XcdBarrier bar; bar.wave = F.wave; bar.bar = (unsigned*)(F.ctl + CW_BAR); bar.x = 0; bar.st = nullptr;
    if (N_LAUNCHES == 1) bar = xcd_barrier_post((unsigned*)(F.ctl + CW_BAR), F.MISC + 8, F.wave, blockIdx.x);
#define GRID_BAR() do { if (N_LAUNCHES == 1) xcd_barrier(bar); } while (0)
#define XCC_BAR(k) do { if (N_LAUNCHES == 1) { if (bar.st[2]) xcc_barrier(bar, (unsigned*)(F.ctl + CW_SPLITW(k))); else xcd_barrier(bar); } } while (0)
    const int lo = args.ph_lo, hi = args.ph_hi;
#ifndef PHASE_MASK
#define PHASE_MASK 0x3ff
#endif
#define IN(k) ((((PHASE_MASK) >> (k)) & 1) && lo <= (k) && (k) < hi)
#define BOTH(k) (IN(k) && IN((k) + 1))
#ifndef PROBE_REPEAT
#define PROBE_REPEAT -1
#endif
constexpr int CW_SPLIT0 = 8192, CW_SPLIT1 = CW_SPLIT0 + 64 * 18;
#define CW_SPLITW(k) (CW_SPLIT0 + 64 * 18 * (k))
static_assert(CW_SPLITW(7) * 4 <= 65536 && CW_SPLIT0 >= CW_BAR + XCD_BAR_WORDS, "split-barrier words inside the memset, clear of the grid barrier's");
#ifndef STG_P6PRE
#define STG_P6PRE(cnt) ((cnt) > 0 ? 1 : 0)
#endif
#ifndef ML_UNIT
#define ML_UNIT(i) ((((i) & 7) << 5) + ((i) >> 3))
#endif
#ifndef STG_P2ALT
#define STG_P2ALT(b) (((b) >> 3) & 1)
#endif
#ifndef STG_SMALL
#define STG_SMALL(b) ((((b) >> 3) & 1) ? 2 : 0)
#endif
#define REP(k) for (int rep_ = 0; rep_ < ((PROBE_REPEAT) == (k) ? 2 : 1); ++rep_, ({ asm volatile("" : "+s"(F.bid), "+s"(F.wave)); }))
    unsigned char* ws = args.ws; unsigned char* z = ws + WS_Z;
    bf16* BUFA = (bf16*)(ws + WS_BUFA);

    if (IN(0)) REP(0) { p0_prologue(F);
        if (N_LAUNCHES == 1 && BOTH(0)) split_arrive(bar, (unsigned*)(F.ctl + CW_SPLIT0));
        if (F.G == 256) {
            p0_weight_items(F, I_IN, 4 * 256 * NWAVES);
            constexpr int SLK0 = (M / 256) * (N1 / 256) - 4 * 256;
            const int sw_ = (F.bid - SLK0) * NWAVES + F.wave;
            p0_weight_items(F, 4 * 256 * NWAVES, NITEMS, F.bid >= SLK0 ? sw_ : (1 << 20), (256 - SLK0) * NWAVES);
        } else p0_weight_items(F, I_IN, NITEMS);
        if (N_LAUNCHES == 1 && BOTH(0)) split_wait(bar, (unsigned*)(F.ctl + CW_SPLIT0)); }

    if (IN(1)) REP(1) {
        pg8::Gemm g{BUFA, (const bf16*)(ws + WS_WIN), M, N1, D}; pg8::StaticOrder S; S.init(M, N1, F.G, F.bid);
        ep::EpiZ E{z};
#if PROBE_REPEAT == 11
        { RepeatOrder<2> S2{S}; pg8::gemm_phase<ep::EpiZ, RepeatOrder<2>, PG8_ALIGN, PG8_SP2>(F.lds + RING_OFF, g, S2, E, F.wave); }
#else
        pg8::gemm_phase<ep::EpiZ, pg8::StaticOrder, PG8_ALIGN, PG8_SP2>(F.lds + RING_OFF, g, S, E, F.wave);
#endif
        if (BOTH(1)) {
            if (N_LAUNCHES == 1) split_arrive(bar, (unsigned*)(F.ctl + CW_SPLITW(2)));
            { const int t_ = F.wave * 64 + lane_fresh(); if (t_ < 64) ((LAS float*)(F.lds + GQ_OFF))[t_] = inp(F, 14)[t_]; else if (t_ < 128) ((LAS float*)(F.lds + GQ_OFF))[t_] = inp(F, 15)[t_ - 64]; }
            if (F.bid < 256) mlstm_p1_pre(F, ML_UNIT(F.bid));
            if (N_LAUNCHES == 1) split_wait(bar, (unsigned*)(F.ctl + CW_SPLITW(2))); }
    }

    if (IN(2)) REP(2) {
        if (!BOTH(1)) { const int t_ = F.wave * 64 + lane_fresh(); if (t_ < 64) ((LAS float*)(F.lds + GQ_OFF))[t_] = inp(F, 14)[t_]; else if (t_ < 128) ((LAS float*)(F.lds + GQ_OFF))[t_] = inp(F, 15)[t_ - 64]; }
        __syncthreads();
#ifndef UNIT_MASK
#define UNIT_MASK 15
#endif
#ifndef PROBE_UNIT
#define PROBE_UNIT 15
#endif
        const int um_ = ((PROBE_REPEAT) == 2 && rep_ == 0) ? (PROBE_UNIT) : 15;
#pragma unroll 1
        for (int i = F.bid; i < 256; i += F.G) { if ((UNIT_MASK & 2) && (um_ & 2)) mlstm_p1_unit(F, ML_UNIT(i), BOTH(1) && i == F.bid); }
        if (N_LAUNCHES == 1 && BOTH(2)) split_arrive(bar, (unsigned*)(F.ctl + CW_SPLIT1));
#define P2_ATTNP() do { _Pragma("unroll 1") for (int i = F.bid; i < 256; i += F.G) { if ((UNIT_MASK & 1) && (um_ & 1)) attn_prompt_unit(F, ML_UNIT(i)); } } while (0)
#define P2_SAMPLE() do { if ((UNIT_MASK & 8) && (um_ & 8)) { float ca[32], cb[32]; int i = F.bid; \
            if (i < 512) mlstm_sample_c0(F, i, ca); \
            _Pragma("unroll 1") for (; i < 512; i += 2 * F.G) { mlstm_sample_unit(F, i, ca, i + F.G, cb); if (i + F.G < 512) mlstm_sample_unit(F, i + F.G, cb, i + 2 * F.G, ca); } } } while (0)
        int alt_ = STG_P2ALT(F.bid); asm volatile("" : "+s"(alt_));
        if (alt_) P2_SAMPLE(); else P2_ATTNP();
#pragma unroll 1
        for (int i = F.bid; i < 256; i += F.G) { if ((UNIT_MASK & 4) && (um_ & 4)) attn_sample_unit(F, i); }
        asm volatile("" : "+s"(alt_));
        if (alt_) P2_ATTNP(); else P2_SAMPLE();
#undef P2_ATTNP
#undef P2_SAMPLE
        if (N_LAUNCHES == 1 && BOTH(2)) { if (F.bid < 256) mlstm_p2_pre(F, ML_UNIT(F.bid));
            split_wait(bar, (unsigned*)(F.ctl + CW_SPLIT1)); }
    }

    if (IN(3)) REP(3) {
#pragma unroll 1
        for (int i = F.bid; i < 256; i += F.G) {
            mlstm_p2_unit(F, ML_UNIT(i), (N_LAUNCHES == 1 && BOTH(2)) && i == F.bid); }
        if (BOTH(3)) { if (N_LAUNCHES == 1) split_arrive(bar, (unsigned*)(F.ctl + CW_SPLITW(4))); }
    }

    if (IN(4)) REP(4) {
#pragma unroll 1
        for (int s_ = 0; s_ < 3; ++s_) {
          if (s_ == (BOTH(3) ? 0 : STG_SMALL(F.bid))) { SmMixK o{(const unsigned char*)(z + Z_GAU), (const unsigned char*)(z + Z_GMU), (bf16*)(z + Z_MIXED)}; small_tile<D, SmMixK, true>(F, (const bf16*)(ws + WS_YH), (const bf16*)(ws + WS_WOA), o);
            if (BOTH(3) && N_LAUNCHES == 1) split_wait(bar, (unsigned*)(F.ctl + CW_SPLITW(4))); }
          else if (s_ == 1) { pg8::Gemm g{(const bf16*)(ws + WS_YH), (const bf16*)(ws + WS_WOA), MP, D, D}; pg8::StaticOrder S; S.init(MP, D, F.G, F.bid);
            ep::EpiMixK E{(const unsigned char*)(z + Z_GAU), (const unsigned char*)(z + Z_GMU), (bf16*)(z + Z_MIXED)};
            pg8::gemm_phase<ep::EpiMixK, pg8::StaticOrder, PG8_ALIGN, PG8_SP2>(F.lds + RING_OFF, g, S, E, F.wave); } }
        if (BOTH(4)) XCC_BAR(5);
    }

    if (IN(5)) REP(5) {
#pragma unroll 1
        for (int s_ = 0; s_ < 3; ++s_) {
          if (s_ == STG_SMALL(F.bid)) { SmX1 o{(const float*)(ws + WS_RS), inp(F, 10), BUFA, (float*)(ws + WS_SSS)}; small_tile<D>(F, (const bf16*)(z + Z_MIXED), (const bf16*)(ws + WS_WOUT), o); }
          else if (s_ == 1) { pg8::Gemm g{(const bf16*)(z + Z_MIXED), (const bf16*)(ws + WS_WOUT), MP, D, D}; pg8::StaticOrder S; S.init(MP, D, F.G, F.bid);
            ep::EpiX1 E{(const float*)(ws + WS_RS), inp(F, 10), BUFA, (float*)(ws + WS_SS)};
            pg8::gemm_phase<ep::EpiX1, pg8::StaticOrder, PG8_ALIGN, PG8_SP2>(F.lds + RING_OFF, g, S, E, F.wave); } }
        if (BOTH(5) && N_LAUNCHES == 1) split_arrive(bar, (unsigned*)(F.ctl + CW_SPLITW(3)));
    }

    if (IN(6)) REP(6) {
        const int nwg_ = (M / 256) * (F2 / 256), rem_ = nwg_ % F.G, nidle_ = rem_ ? F.G - rem_ : F.G, j_ = rem_ ? F.bid - rem_ : F.bid;
        ListOrder L{0, 0};
        const int tq_ = 256 / nidle_, tleft_ = 256 - tq_ * nidle_;
        if (j_ >= 0) { L.start = j_ * tq_; L.count = tq_; }
        const int pre_ = STG_P6PRE(L.count);
#pragma unroll 1
        for (int s_ = 0; s_ < 3; ++s_) {
          if (s_ == 1) {
            pg8::Gemm g{BUFA, (const bf16*)(ws + WS_WUP), M, F2, D}; pg8::StaticOrder S; S.init(M, F2, F.G, F.bid);
            ep::EpiConv E{(const float*)(ws + WS_SS), (const float*)(ws + WS_SSS), inp(F, 23), inp(F, 24), inp(F, 7), (bf16*)(z + Z_ACT), (float*)(z + Z_UB), F.out + O_CONVS, (LAS float*)(F.lds + PARAM_OFF)};
            pg8::gemm_phase<ep::EpiConv, pg8::StaticOrder, PG8_ALIGN, PG8_SP2>(F.lds + RING_OFF, g, S, E, F.wave);
          } else {
            if (s_ == 0) { SmT o{(bf16*)(z + Z_TPLE)}; small_tile<PLE>(F, (const bf16*)(ws + WS_PB), (const bf16*)(ws + WS_WPLE), o);
              if (F.bid < tleft_ * 32) { const int idx_ = tq_ * nidle_ + (F.bid >> 5), wi_ = F.bid & 31;
                small_tile<PLE>(F, (const bf16*)(ws + WS_PB), (const bf16*)(ws + WS_WPLE), o, (idx_ >> 2) * 256 + 64 * (wi_ >> 3), (idx_ & 3) * 256 + 32 * (wi_ & 7)); } }
            ListOrder L2{s_ == 0 ? L.start : L.start + pre_, s_ == 0 ? pre_ : L.count - pre_};
            pg8::Gemm g2{(const bf16*)(ws + WS_PB), (const bf16*)(ws + WS_WPLE), MP, D, PLE}; ep::EpiT E2{(bf16*)(z + Z_TPLE)};
            pg8::gemm_phase<ep::EpiT, ListOrder, PG8_ALIGN, PG8_SP2>(F.lds + RING_OFF, g2, L2, E2, F.wave);
            __syncthreads();
            if (s_ == 0 && BOTH(5) && N_LAUNCHES == 1) split_wait(bar, (unsigned*)(F.ctl + CW_SPLITW(3))); } }
        if (BOTH(6)) GRID_BAR();
    }

    if (IN(7)) REP(7) { }

    if (IN(8)) {
        { pg8::StaticOrder S0; S0.init(MP, D, F.G, F.bid); pg8::Unit u0; for (int i = 0; S0.next(i, u0); ++i) conv_fixup_panel(F, u0.pm, u0.pn); }
#if PROBE_REPEAT == 18
        { SmX2<true> o{BUFA}; small_tile<DFF>(F, (const bf16*)(z + Z_ACT), (const bf16*)(ws + WS_WDN), o); }
#endif
#if PROBE_REPEAT == 8
        { { SmX2<true> o{BUFA}; small_tile<DFF>(F, (const bf16*)(z + Z_ACT), (const bf16*)(ws + WS_WDN), o); }
          pg8::Gemm g{(const bf16*)(z + Z_ACT), (const bf16*)(ws + WS_WDN), MP, D, DFF}; pg8::StaticOrder S; S.init(MP, D, F.G, F.bid);
          ep::EpiX2<true> E{BUFA};
          pg8::gemm_phase<ep::EpiX2<true>, pg8::StaticOrder, PG8_ALIGN, PG8_SP2>(F.lds + RING_OFF, g, S, E, F.wave); GRID_BAR(); }
#endif
#pragma unroll 1
        for (int s_ = 0; s_ < 3; ++s_) {
          if (s_ == STG_SMALL(F.bid)) { SmX2<> o{BUFA}; small_tile<DFF>(F, (const bf16*)(z + Z_ACT), (const bf16*)(ws + WS_WDN), o); }
          else if (s_ == 1) { pg8::Gemm g{(const bf16*)(z + Z_ACT), (const bf16*)(ws + WS_WDN), MP, D, DFF}; pg8::StaticOrder S; S.init(MP, D, F.G, F.bid);
            ep::EpiX2<> E{BUFA};
            pg8::gemm_phase<ep::EpiX2<>, pg8::StaticOrder, PG8_ALIGN, PG8_SP2>(F.lds + RING_OFF, g, S, E, F.wave); } }
        if (BOTH(8)) XCC_BAR(6);
    }

    if (IN(9)) {
#if PROBE_REPEAT == 9
        { { SmY<true> o{BUFA, F.out + O_Y, (const bf16*)(z + Z_TPLE)}; small_tile<D>(F, BUFA, (const bf16*)(ws + WS_WG), o); }
          pg8::Gemm g{BUFA, (const bf16*)(ws + WS_WG), MP, D, D}; pg8::StaticOrder S; S.init(MP, D, F.G, F.bid);
          ep::EpiY<true> E{BUFA, F.out + O_Y, (const bf16*)(z + Z_TPLE)};
          pg8::gemm_phase<ep::EpiY<true>, pg8::StaticOrder, PG8_ALIGN, PG8_SP2>(F.lds + RING_OFF, g, S, E, F.wave); GRID_BAR(); }
#endif
#pragma unroll 1
        for (int s_ = 0; s_ < 3; ++s_) {
          if (s_ == STG_SMALL(F.bid)) { SmY<> o{BUFA, F.out + O_Y, (const bf16*)(z + Z_TPLE)}; small_tile<D>(F, BUFA, (const bf16*)(ws + WS_WG), o); }
          else if (s_ == 1) { pg8::Gemm g{BUFA, (const bf16*)(ws + WS_WG), MP, D, D}; pg8::StaticOrder S; S.init(MP, D, F.G, F.bid);
            ep::EpiY<> E{BUFA, F.out + O_Y, (const bf16*)(z + Z_TPLE)};
            pg8::gemm_phase<ep::EpiY<>, pg8::StaticOrder, PG8_ALIGN, PG8_SP2>(F.lds + RING_OFF, g, S, E, F.wave); } }
    }
#undef IN
#undef BOTH
#undef GRID_BAR
}

extern "C" void kernel_launch(void* const* d_in, const int* in_sizes, int n_in, void* d_out, int out_size, void* d_ws, size_t ws_size, hipStream_t stream) {
    static int grid = 0;
    if (grid == 0) {
        if (n_in != 28 || in_sizes[0] != MP * D || (size_t)out_size != O_END || ws_size < WS_TOTAL) {
            fprintf(stderr, "kernel_launch: built for 28 inputs, x_prompt of %d floats, out of %zu floats, >= %zu bytes of workspace; got n_in %d, in0 %d, out %d, ws %zu; nothing launched\n", MP * D, (size_t)O_END, (size_t)WS_TOTAL, n_in, n_in > 0 ? in_sizes[0] : -1, out_size, ws_size); grid = -1; return; }
        int dev = 0, cus = 0, per_cu = 0;
        if (hipGetDevice(&dev) != hipSuccess || hipDeviceGetAttribute(&cus, hipDeviceAttributeMultiprocessorCount, dev) != hipSuccess) { fprintf(stderr, "kernel_launch: device query failed\n"); grid = -1; return; }
        if (hipFuncSetAttribute((const void*)hybrid_fwd, hipFuncAttributeMaxDynamicSharedMemorySize, LDS_BYTES) != hipSuccess) { fprintf(stderr, "kernel_launch: hipFuncSetAttribute failed\n"); grid = -1; return; }
        if (hipOccupancyMaxActiveBlocksPerMultiprocessor(&per_cu, (const void*)hybrid_fwd, NWAVES * 64, LDS_BYTES) != hipSuccess || per_cu < 1) { fprintf(stderr, "kernel_launch: occupancy query reports %d workgroups per CU; nothing launched\n", per_cu); (void)hipGetLastError(); grid = -1; return; }
        (void)hipGetLastError();
        grid = cus;
    }
    if (grid < 0) return;
    static_assert((CW_BAR + XCD_BAR_WORDS) * 4 <= 65536, "control words inside the memset");
    if (hipMemsetAsync((char*)d_ws + WS_CTL, 0, 65536, stream) != hipSuccess)     { fprintf(stderr, "kernel_launch: hipMemsetAsync failed\n"); return; }
    Args a{};
    for (int i = 0; i < 28; ++i) a.in[i] = (const float*)d_in[i];
    a.out = (float*)d_out; a.ws = (unsigned char*)d_ws;
    for (int li = 0; li < N_LAUNCHES; ++li) {
        a.ph_lo = (N_LAUNCHES == PER_PHASE) ? li : 0; a.ph_hi = (N_LAUNCHES == PER_PHASE) ? li + 1 : PER_PHASE; a.li = li;
        hipLaunchKernelGGL(hybrid_fwd, dim3(grid), dim3(NWAVES * 64), LDS_BYTES, stream, a);
        const hipError_t le = hipPeekAtLastError();
        if (le != hipSuccess) { fprintf(stderr, "kernel_launch: launch %d failed: %s\n", li, hipGetErrorName(le)); break; }
    }
}
```
